# Optimizing an MI355X kernel written in HIP

```python
import math
import jax, jax.numpy as jnp
from jax import lax
import numpy as np

D_MODEL = 2048
BATCH = 8
SEQ = 2048
DEPTH = 1

GRID_W = 64
CTX_LEN = 256
HEAD_DIM = 128
N_HEADS = 8
N_KV_HEADS = 2
GROUP = N_HEADS // N_KV_HEADS
WINDOW = 128
BLOCK = 128
NBAND = -(-WINDOW // BLOCK)
BAND = (2 * NBAND + 1) * BLOCK
ROT_HALF = HEAD_DIM // 2
ROPE_BASE = 10000.0
SSM_WIDTH = D_MODEL // 4
SSM_GROUP = 16
SSM_GROUPS = SSM_WIDTH // SSM_GROUP
SSM_STATE = 64
D_FF = 4 * D_MODEL
Q_W = N_HEADS * HEAD_DIM
KV_W = N_KV_HEADS * HEAD_DIM
IN_COLS = Q_W + 2 * KV_W + SSM_WIDTH + 2 * D_MODEL
SPLIT_AT = (Q_W, Q_W + KV_W, Q_W + 2 * KV_W, Q_W + 2 * KV_W + SSM_WIDTH,
            Q_W + 2 * KV_W + SSM_WIDTH + D_MODEL)
ALPHA = (2.0 * DEPTH) ** 0.25
BETA = (8.0 * DEPTH) ** -0.25
LN_EPS = 1e-6
NEG_INF = -1e30

kernel_name = 'hybrid_dit_swa_s5_block'


def layer_norm(x):
    xf = x.astype(jnp.float32)
    mu = jnp.mean(xf, -1, keepdims=True)
    var = jnp.mean(jnp.square(xf - mu), -1, keepdims=True)
    return ((xf - mu) * lax.rsqrt(var + LN_EPS)).astype(x.dtype)


def post_norm(x, g, b):
    return layer_norm(x) * g + b


def axial_rope_tables(n_tokens):
    rows = n_tokens // GRID_W
    row = jnp.repeat(jnp.arange(rows), GRID_W)
    col = jnp.tile(jnp.arange(GRID_W), rows)
    n_freq = ROT_HALF // 2
    freqs = ROPE_BASE ** (-jnp.arange(n_freq, dtype=jnp.float32) / n_freq)
    ang_r = row.astype(jnp.float32)[:, None] * freqs
    ang_c = col.astype(jnp.float32)[:, None] * freqs
    ang = jnp.concatenate([ang_r, ang_r, ang_c, ang_c], -1)
    return jnp.cos(ang), jnp.sin(ang)


def rotate_axial(x):
    h = ROT_HALF // 2
    a, b = x[..., :ROT_HALF], x[..., ROT_HALF:]
    return jnp.concatenate([-a[..., h:], a[..., :h], -b[..., h:], b[..., :h]], -1)


def apply_rope(x, cos, sin):
    cos = cos[:, None, :].astype(x.dtype)
    sin = sin[:, None, :].astype(x.dtype)
    return x * cos + rotate_axial(x) * sin


def windowed_gqa_latent(q, k, v, k_ctx, v_ctx, sink):
    bsz, n_tok = q.shape[0], q.shape[1]
    n_ctx = k_ctx.shape[1]
    nb = n_tok // BLOCK
    scale = HEAD_DIM ** -0.5
    qb = q.reshape(bsz, nb, BLOCK, N_KV_HEADS, GROUP, HEAD_DIM)

    def band(t):
        tp = jnp.pad(t, ((0, 0), (NBAND * BLOCK, NBAND * BLOCK), (0, 0), (0, 0)))
        tp = tp.reshape(bsz, nb + 2 * NBAND, BLOCK, N_KV_HEADS, HEAD_DIM)
        return jnp.concatenate([tp[:, j:j + nb] for j in range(2 * NBAND + 1)], axis=2)

    kb, vb = band(k), band(v)
    q_pos = jnp.arange(n_tok).reshape(nb, BLOCK)
    k_pos = (jnp.arange(nb)[:, None] - NBAND) * BLOCK + jnp.arange(BAND)[None, :]
    valid = ((jnp.abs(q_pos[:, :, None] - k_pos[:, None, :]) <= WINDOW)
             & (k_pos >= 0)[:, None, :] & (k_pos < n_tok)[:, None, :])
    s_loc = jnp.einsum('bnqkgd,bnjkd->bnkgqj', qb, kb, preferred_element_type=jnp.float32) * scale
    s_loc = jnp.where(valid[None, :, None, None], s_loc, NEG_INF)
    s_ctx = jnp.einsum('bnqkgd,bckd->bnkgqc', qb, k_ctx, preferred_element_type=jnp.float32) * scale
    s_sink = jnp.broadcast_to(sink.astype(jnp.float32).reshape(1, 1, N_KV_HEADS, GROUP, 1, 1),
                              s_loc.shape[:-1] + (1,))
    p = jax.nn.softmax(jnp.concatenate([s_loc, s_ctx, s_sink], -1), axis=-1).astype(v.dtype)
    out = (jnp.einsum('bnkgqj,bnjkd->bnqkgd', p[..., :BAND], vb)
           + jnp.einsum('bnkgqc,bckd->bnqkgd', p[..., BAND:BAND + n_ctx], v_ctx))
    return out.reshape(bsz, n_tok, Q_W)


def context_attention(q, k, v, sink):
    bsz, n_ctx = q.shape[0], q.shape[1]
    scale = HEAD_DIM ** -0.5
    qg = q.reshape(bsz, n_ctx, N_KV_HEADS, GROUP, HEAD_DIM)
    s = jnp.einsum('bqkgd,bckd->bkgqc', qg, k, preferred_element_type=jnp.float32) * scale
    s_sink = jnp.broadcast_to(sink.astype(jnp.float32).reshape(1, N_KV_HEADS, GROUP, 1, 1),
                              s.shape[:-1] + (1,))
    p = jax.nn.softmax(jnp.concatenate([s, s_sink], -1), axis=-1).astype(v.dtype)
    out = jnp.einsum('bkgqc,bckd->bqkgd', p[..., :n_ctx], v)
    return out.reshape(bsz, n_ctx, Q_W)


def s5_discretise(a_re, a_im, log_dt, b_re, b_im):
    lam = lax.complex(a_re.astype(jnp.float32), a_im.astype(jnp.float32))
    dt = jnp.exp(log_dt.astype(jnp.float32))[:, None]
    lam_bar = jnp.exp(lam * dt)
    b = lax.complex(b_re.astype(jnp.float32), b_im.astype(jnp.float32))
    b_bar = ((lam_bar - 1.0) / lam)[..., None] * b
    return lam_bar, b_bar


def _linear_recurrence(e1, e2):
    a1, b1 = e1
    a2, b2 = e2
    return a1 * a2, a2 * b1 + b2


def s5_scan(u, lam_bar, b_bar, reverse, s0=None):
    bu = jnp.einsum('blgh,gph->blgp', u, b_bar)
    if s0 is not None:
        edge = u.shape[1] - 1 if reverse else 0
        bu = bu.at[:, edge].add(lam_bar * s0)
    a = jnp.broadcast_to(lam_bar, bu.shape)
    _, s = lax.associative_scan(_linear_recurrence, (a, bu), reverse=reverse, axis=1)
    return s


def s5_readout(s, c_re, c_im):
    cmat = lax.complex(c_re.astype(jnp.float32), c_im.astype(jnp.float32))
    return jnp.real(jnp.einsum('blgp,ghp->blgh', s, cmat))


def s5_bidirectional(u_lat, u_ctx, a_re, a_im, log_dt, b_re, b_im, c_re, c_im, d_skip, need_ctx):
    ul = u_lat.astype(jnp.float32).reshape(u_lat.shape[0], u_lat.shape[1], SSM_GROUPS, SSM_GROUP)
    uc = u_ctx.astype(jnp.float32).reshape(u_ctx.shape[0], u_ctx.shape[1], SSM_GROUPS, SSM_GROUP)
    dsk = d_skip.astype(jnp.float32)
    y_lat = dsk * ul
    y_ctx = dsk * uc
    for direction, reverse in enumerate((False, True)):
        lam_bar, b_bar = s5_discretise(a_re[direction], a_im[direction], log_dt[direction],
                                       b_re[direction], b_im[direction])
        s_ctx = s5_scan(uc, lam_bar, b_bar, reverse)
        s_init = s_ctx[:, 0] if reverse else s_ctx[:, -1]
        s_lat = s5_scan(ul, lam_bar, b_bar, reverse, s_init)
        y_lat = y_lat + s5_readout(s_lat, c_re[direction], c_im[direction])
        if need_ctx:
            y_ctx = y_ctx + s5_readout(s_ctx, c_re[direction], c_im[direction])
    y_lat = y_lat.reshape(u_lat.shape).astype(u_lat.dtype)
    y_ctx = y_ctx.reshape(u_ctx.shape).astype(u_ctx.dtype) if need_ctx else None
    return y_lat, y_ctx


def gelu_glu(y, w_glu):
    z = jax.nn.gelu(y) @ w_glu
    return z[..., :SSM_WIDTH] * jax.nn.sigmoid(z[..., SSM_WIDTH:])


def hybrid_mixer(h_lat, h_ctx, w_in, attn_sink, a_re, a_im, log_dt, b_re, b_im, c_re, c_im, d_skip,
                 w_glu, w_attn_up, w_ssm_up, w_out, need_ctx):
    q_l, k_l, v_l, u_l, ga_l, gs_l = jnp.split(h_lat @ w_in, SPLIT_AT, axis=-1)
    q_c, k_c, v_c, u_c, ga_c, gs_c = jnp.split(h_ctx @ w_in, SPLIT_AT, axis=-1)

    def heads(t, n):
        return t.reshape(t.shape[0], t.shape[1], n, HEAD_DIM)

    cos, sin = axial_rope_tables(h_lat.shape[1])
    q_l = apply_rope(heads(q_l, N_HEADS), cos, sin)
    k_l = apply_rope(heads(k_l, N_KV_HEADS), cos, sin)
    k_c, v_c = heads(k_c, N_KV_HEADS), heads(v_c, N_KV_HEADS)
    attn_l = windowed_gqa_latent(q_l, k_l, heads(v_l, N_KV_HEADS), k_c, v_c, attn_sink)
    ssm_l, ssm_c = s5_bidirectional(u_l, u_c, a_re, a_im, log_dt, b_re, b_im, c_re, c_im, d_skip, need_ctx)

    def merge(attn, ssm, ga, gs):
        attn_d = attn @ w_attn_up
        ssm_d = gelu_glu(ssm, w_glu) @ w_ssm_up
        return (jax.nn.sigmoid(ga) * attn_d + jax.nn.sigmoid(gs) * ssm_d) @ w_out

    y_lat = merge(attn_l, ssm_l, ga_l, gs_l)
    y_ctx = None
    if need_ctx:
        attn_c = context_attention(heads(q_c, N_HEADS), k_c, v_c, attn_sink)
        y_ctx = merge(attn_c, ssm_c, ga_c, gs_c)
    return y_lat, y_ctx


def squared_relu_mlp(h, w1, b1, w2, b2):
    return jnp.square(jax.nn.relu(h @ w1 + b1)) @ w2 + b2


def setup_inputs(seed: int = 0) -> dict:
    key = jax.random.key(seed)
    ks = jax.random.split(key, 28)
    f32 = jnp.float32

    def nrm(k, shape, s):
        return jax.random.normal(k, shape, f32) * s

    G, P, HG = SSM_GROUPS, SSM_STATE, SSM_GROUP
    return {
        'x': nrm(ks[0], (BATCH, SEQ, D_MODEL), 1.0),
        'c': nrm(ks[1], (BATCH, D_MODEL), 1.0),
        'ctx': nrm(ks[2], (BATCH, CTX_LEN, D_MODEL), 1.0),
        'c_ctx': nrm(ks[3], (D_MODEL,), 1.0),
        'w_ada': nrm(ks[4], (DEPTH, D_MODEL, 6 * D_MODEL), D_MODEL ** -0.5),
        'b_ada': nrm(ks[5], (DEPTH, 6 * D_MODEL), 0.01),
        'w_in': nrm(ks[6], (DEPTH, D_MODEL, IN_COLS), D_MODEL ** -0.5),
        'attn_sink': nrm(ks[7], (DEPTH, N_HEADS), 0.5),
        'ssm_a_re': -0.5 + nrm(ks[8], (DEPTH, 2, G, P), 0.01),
        'ssm_a_im': jnp.pi * jnp.arange(P, dtype=f32) + nrm(ks[9], (DEPTH, 2, G, P), 0.01),
        'ssm_log_dt': jax.random.uniform(ks[10], (DEPTH, 2, G), f32, math.log(1e-3), math.log(1e-1)),
        'ssm_b_re': nrm(ks[11], (DEPTH, 2, G, P, HG), (2 * HG) ** -0.5),
        'ssm_b_im': nrm(ks[12], (DEPTH, 2, G, P, HG), (2 * HG) ** -0.5),
        'ssm_c_re': nrm(ks[13], (DEPTH, 2, G, HG, P), P ** -0.5),
        'ssm_c_im': nrm(ks[14], (DEPTH, 2, G, HG, P), P ** -0.5),
        'ssm_d': nrm(ks[15], (DEPTH, G, HG), 0.5),
        'w_glu': nrm(ks[16], (DEPTH, SSM_WIDTH, 2 * SSM_WIDTH), SSM_WIDTH ** -0.5),
        'w_attn_up': nrm(ks[17], (DEPTH, Q_W, D_MODEL), Q_W ** -0.5),
        'w_ssm_up': nrm(ks[18], (DEPTH, SSM_WIDTH, D_MODEL), SSM_WIDTH ** -0.5),
        'w_out': nrm(ks[19], (DEPTH, D_MODEL, D_MODEL), BETA * D_MODEL ** -0.5),
        'ln_mix_g': 1.0 + nrm(ks[20], (DEPTH, D_MODEL), 0.01),
        'ln_mix_b': nrm(ks[21], (DEPTH, D_MODEL), 0.01),
        'w_mlp1': nrm(ks[22], (DEPTH, D_MODEL, D_FF), D_MODEL ** -0.5),
        'b_mlp1': nrm(ks[23], (DEPTH, D_FF), 0.01),
        'w_mlp2': nrm(ks[24], (DEPTH, D_FF, D_MODEL), BETA * D_FF ** -0.5),
        'b_mlp2': nrm(ks[25], (DEPTH, D_MODEL), 0.01),
        'ln_mlp_g': 1.0 + nrm(ks[26], (DEPTH, D_MODEL), 0.01),
        'ln_mlp_b': nrm(ks[27], (DEPTH, D_MODEL), 0.01),
    }


def reference(x, c, ctx, c_ctx, w_ada, b_ada, w_in, attn_sink, ssm_a_re, ssm_a_im, ssm_log_dt,
              ssm_b_re, ssm_b_im, ssm_c_re, ssm_c_im, ssm_d, w_glu, w_attn_up, w_ssm_up, w_out,
              ln_mix_g, ln_mix_b, w_mlp1, b_mlp1, w_mlp2, b_mlp2, ln_mlp_g, ln_mlp_b):
    ctx_s = ctx
    for layer in range(DEPTH):
        last = layer == DEPTH - 1
        mod_lat = jax.nn.silu(c) @ w_ada[layer] + b_ada[layer]
        mod_ctx = jax.nn.silu(c_ctx) @ w_ada[layer] + b_ada[layer]
        sh1, sc1, g1, sh2, sc2, g2 = jnp.split(mod_lat[:, None, :], 6, axis=-1)
        csh1, csc1, cg1, csh2, csc2, cg2 = jnp.split(mod_ctx, 6, axis=-1)

        h_lat = layer_norm(x) * (1.0 + sc1) + sh1
        h_ctx = layer_norm(ctx_s) * (1.0 + csc1) + csh1
        y_lat, y_ctx = hybrid_mixer(h_lat, h_ctx, w_in[layer], attn_sink[layer],
                                    ssm_a_re[layer], ssm_a_im[layer], ssm_log_dt[layer],
                                    ssm_b_re[layer], ssm_b_im[layer], ssm_c_re[layer], ssm_c_im[layer],
                                    ssm_d[layer], w_glu[layer], w_attn_up[layer], w_ssm_up[layer],
                                    w_out[layer], not last)
        x = post_norm(ALPHA * x + g1 * y_lat, ln_mix_g[layer], ln_mix_b[layer])
        h2 = layer_norm(x) * (1.0 + sc2) + sh2
        x = post_norm(ALPHA * x + g2 * squared_relu_mlp(h2, w_mlp1[layer], b_mlp1[layer],
                                                        w_mlp2[layer], b_mlp2[layer]),
                      ln_mlp_g[layer], ln_mlp_b[layer])
        if not last:
            ctx_s = post_norm(ALPHA * ctx_s + cg1 * y_ctx, ln_mix_g[layer], ln_mix_b[layer])
            hc2 = layer_norm(ctx_s) * (1.0 + csc2) + csh2
            ctx_s = post_norm(ALPHA * ctx_s + cg2 * squared_relu_mlp(hc2, w_mlp1[layer], b_mlp1[layer],
                                                                   w_mlp2[layer], b_mlp2[layer]),
                              ln_mlp_g[layer], ln_mlp_b[layer])
    return x
```

```cpp
#include <hip/hip_runtime.h>
#include <hip/hip_cooperative_groups.h>
#include <cstdio>
#include <cstdint>
namespace cg = cooperative_groups;

#ifndef N_LAUNCH_MODE
#define N_LAUNCH_MODE 1
#endif

#define LAS __attribute__((address_space(3)))
typedef unsigned short bf16_t;
typedef short bf16x8 __attribute__((ext_vector_type(8)));
typedef float f32x4 __attribute__((ext_vector_type(4)));
typedef float f32x2 __attribute__((ext_vector_type(2)));
typedef unsigned u32x4 __attribute__((ext_vector_type(4)));
typedef unsigned u32x2 __attribute__((ext_vector_type(2)));

constexpr int DM = 2048, NB = 8, SEQ = 2048, CTXL = 256, HD = 128, NH = 8;
constexpr int QW = 1024, SW = 512, INC = 6144, DFF = 8192;
constexpr int MLAT = NB * SEQ, MCTX = NB * CTXL, MALL = MLAT + MCTX;
constexpr int KROWS = SEQ + CTXL;
constexpr int S5ROWS = 1280;
constexpr float ALPHA_F = 1.189207115002721f;
constexpr float LN_EPS = 1e-6f;
constexpr float LOG2E = 1.4426950408889634f;
constexpr float QSCALE = 0.08838834764831845f * LOG2E;
constexpr int NSTEPS = 15;

constexpr size_t MiB = 1u << 20;
constexpr size_t WS_WTIN = 1 * MiB, WS_WTGLU = 25 * MiB, WS_WTAUP = 26 * MiB, WS_WTSUP = 30 * MiB, WS_WTOUT = 32 * MiB, WS_WTM1 = 40 * MiB, WS_WTM2 = 72 * MiB;
constexpr size_t WS_WMAT = 104 * MiB, WS_MMAT = 108 * MiB, WS_MOD = 116 * MiB, WS_ROPE = 117 * MiB, WS_LAMT = 117 * MiB + 512 * 1024;
constexpr size_t WS_HALL = 128 * MiB;
constexpr size_t WS_ATTN = 128 * MiB;
constexpr size_t WS_SLOC = 160 * MiB;
constexpr size_t WS_QB = 200 * MiB, WS_KB = 232 * MiB, WS_VT = 241 * MiB;
constexpr size_t WS_SACT = 250 * MiB;
constexpr size_t WS_MERG = 200 * MiB;
constexpr size_t WS_U = 266 * MiB;
constexpr size_t WS_SGA = 306 * MiB, WS_SGS = 370 * MiB;
constexpr size_t WS_SGLU = 434 * MiB;
constexpr size_t WS_HID = 128 * MiB;
constexpr size_t WS_H2 = 384 * MiB;
constexpr size_t WS_NEED = 450 * MiB;

constexpr int LDS_BYTES = 147456;

struct Params { const float* in[28]; float* out; unsigned char* ws; int lo, hi; };
#define KP ((const __attribute__((address_space(4))) Params*)__builtin_amdgcn_kernarg_segment_ptr())
__device__ __forceinline__ int lane_id() { int l; asm volatile("v_mbcnt_lo_u32_b32 %0, -1, 0\n\tv_mbcnt_hi_u32_b32 %0, -1, %0" : "=v"(l)); return l; }

__device__ __forceinline__ unsigned f2bf(float f) { unsigned u = __builtin_bit_cast(unsigned, f); return (u + 0x7fffu + ((u >> 16) & 1u)) >> 16; }
__device__ __forceinline__ unsigned pk2(float lo, float hi) { return f2bf(lo) | (f2bf(hi) << 16); }
__device__ __forceinline__ unsigned cvt_pk_bf16(float lo, float hi) { unsigned r; asm volatile("v_cvt_pk_bf16_f32 %0, %1, %2" : "=v"(r) : "v"(lo), "v"(hi)); return r; }
__device__ __forceinline__ float bflo(unsigned w) { return __builtin_bit_cast(float, w << 16); }
__device__ __forceinline__ float bfhi(unsigned w) { return __builtin_bit_cast(float, w & 0xffff0000u); }
__device__ __forceinline__ float sigmoidf_(float x) { return 1.f / (1.f + __expf(-x)); }
__device__ __forceinline__ float gelu_tanh(float x) { const float u = 1.5957691216057308f * (x + 0.044715f * x * x * x); return x * sigmoidf_(u); }
__device__ __forceinline__ float wave_sum(float v) {
#pragma unroll
    for (int o = 1; o < 64; o <<= 1) v += __shfl_xor(v, o);
    return v;
}
#define LDS_WAIT() asm volatile("s_waitcnt lgkmcnt(0)" ::: "memory")

constexpr int BM = 256, BK = 64, HALF = 128, HTB = HALF * BK * 2;
__device__ __forceinline__ int lds_byte(int r, int c) { const int st = (r >> 4) * 2 + (c >> 5), rr = r & 15, cc = c & 31, ob = rr * 64 + cc * 2; return st * 1024 + (ob ^ (((ob >> 9) & 1) << 5)); }
__device__ __forceinline__ void stage_rc(int b, int& R, int& C) { const int st = b / 1024, sb = b % 1024, swz = sb ^ (((sb >> 9) & 1) << 5); R = (st >> 1) * 16 + swz / 64; C = (st & 1) * 32 + (swz % 64) / 2; }
__device__ __forceinline__ int perm32(int rho) { const int n = rho >> 4, i = rho & 15; return 8 * (i >> 2) + 4 * n + (i & 3); }

struct Unit { int pm, pn; };
struct Gemm { const bf16_t* A; const bf16_t* Bt; int lda, ldb, K; };
struct Order {
    int mode, nM, nN, nwg, G, c;
    __device__ __forceinline__ bool next(int i, Unit& u) const {
        const int L = i * G + c; if (L >= nwg) return false;
        if (mode == 2) { const int g = L / nM, ii = L - g * nM; u.pm = g * 5 + ii; u.pn = g; return true; }
        if (mode == 1 && L >= 1536) { const int t = L - 1536; u.pm = 64 + (t >> 2); u.pn = 4 + (t & 3); return true; }
        const int nw = nM * nN; int wgid = L; { const int q = nw / 8, r = nw % 8, xcd = wgid % 8, off = wgid / 8; wgid = (xcd < r ? xcd * (q + 1) : r * (q + 1) + (xcd - r) * q) + off; }
        const int nig = 8 * nN, gid = wgid / nig, fm = gid * 8, gsz = (nM - fm) < 8 ? (nM - fm) : 8;
        u.pm = fm + ((wgid % nig) % gsz); u.pn = (wgid % nig) / gsz; return true;
    }
};

enum EpiMode { E_WIN = 0, E_S5A, E_S5C, E_GLU, E_AUP, E_SUP, E_WOUT, E_M1, E_M2 };

template <int mode> struct Epi {
    unsigned char* ws; const float* pa; const float* pb; float* outp;
    __device__ __forceinline__ void operator()(const f32x4 (&acc)[2][2][4][2], const Unit& u, int wr, int wc, int fr, int fq) const {
        const int row0 = u.pm * BM + wr * 64 + fr;
        const int cb = wc * 32 + 8 * fq;
        if constexpr (mode == E_M1) {
            bf16_t* O = (bf16_t*)(ws + WS_HID); const float* b1 = pa;
            f32x4 bv[2][2];
#pragma unroll
            for (int bj = 0; bj < 2; ++bj)
#pragma unroll
                for (int n = 0; n < 2; ++n) bv[bj][n] = *(const f32x4*)(b1 + u.pn * BM + bj * HALF + cb + 4 * n);
#pragma unroll
            for (int ai = 0; ai < 2; ++ai)
#pragma unroll
                for (int m = 0; m < 4; ++m) { bf16_t* rowp = O + (size_t)(row0 + ai * HALF + m * 16) * DFF + u.pn * BM + cb;
#pragma unroll
                    for (int bj = 0; bj < 2; ++bj) { f32x4 v0 = acc[ai][bj][m][0] + bv[bj][0], v1 = acc[ai][bj][m][1] + bv[bj][1];
#pragma unroll
                        for (int j = 0; j < 4; ++j) { const float a = fmaxf(v0[j], 0.f), b = fmaxf(v1[j], 0.f); v0[j] = a * a; v1[j] = b * b; }
                        u32x4 w; w.x = cvt_pk_bf16(v0[0], v0[1]); w.y = cvt_pk_bf16(v0[2], v0[3]); w.z = cvt_pk_bf16(v1[0], v1[1]); w.w = cvt_pk_bf16(v1[2], v1[3]);
                        *(u32x4*)(rowp + bj * HALF) = w; } }
        } else if constexpr (mode == E_M2 || mode == E_WOUT) {
            const bool m2 = (mode == E_M2);
            const float* base = m2 ? (const float*)outp : pa; float* out = outp;
            const float* mod = (const float*)(ws + WS_MOD) + (size_t)(u.pm >> 3) * 12288 + (m2 ? 10240 : 4096);
            const float* b2 = pa;
            f32x4 gv[2][2], bv[2][2];
#pragma unroll
            for (int bj = 0; bj < 2; ++bj)
#pragma unroll
                for (int n = 0; n < 2; ++n) { const int c = u.pn * BM + bj * HALF + cb + 4 * n; gv[bj][n] = *(const f32x4*)(mod + c);
                    bv[bj][n] = m2 ? *(const f32x4*)(b2 + c) : (f32x4){0.f, 0.f, 0.f, 0.f}; }
#pragma unroll
            for (int ai = 0; ai < 2; ++ai)
#pragma unroll
                for (int m = 0; m < 4; ++m) { const size_t ro = (size_t)(row0 + ai * HALF + m * 16) * DM + u.pn * BM + cb;
#pragma unroll
                    for (int bj = 0; bj < 2; ++bj)
#pragma unroll
                        for (int n = 0; n < 2; ++n) { const f32x4 xb = *(const f32x4*)(base + ro + bj * HALF + 4 * n);
                            const f32x4 v = xb * ALPHA_F + gv[bj][n] * (acc[ai][bj][m][n] + bv[bj][n]);
                            *(f32x4*)(out + ro + bj * HALF + 4 * n) = v; } }
        } else if constexpr (mode == E_AUP || mode == E_SUP) {
            const bool sup = (mode == E_SUP);
            bf16_t* MG = (bf16_t*)(ws + WS_MERG); const bf16_t* SG = (const bf16_t*)(ws + (sup ? WS_SGS : WS_SGA));
#pragma unroll
            for (int ai = 0; ai < 2; ++ai)
#pragma unroll
                for (int m = 0; m < 4; ++m) { const size_t ro = (size_t)(row0 + ai * HALF + m * 16) * DM + u.pn * BM + cb;
#pragma unroll
                    for (int bj = 0; bj < 2; ++bj) { const u32x4 g = *(const u32x4*)(SG + ro + bj * HALF);
                        f32x4 v0 = acc[ai][bj][m][0], v1 = acc[ai][bj][m][1];
                        v0[0] *= bflo(g.x); v0[1] *= bfhi(g.x); v0[2] *= bflo(g.y); v0[3] *= bfhi(g.y);
                        v1[0] *= bflo(g.z); v1[1] *= bfhi(g.z); v1[2] *= bflo(g.w); v1[3] *= bfhi(g.w);
                        if (sup) { const u32x4 o = *(const u32x4*)(MG + ro + bj * HALF);
                            v0[0] += bflo(o.x); v0[1] += bfhi(o.x); v0[2] += bflo(o.y); v0[3] += bfhi(o.y);
                            v1[0] += bflo(o.z); v1[1] += bfhi(o.z); v1[2] += bflo(o.w); v1[3] += bfhi(o.w); }
                        u32x4 w; w.x = cvt_pk_bf16(v0[0], v0[1]); w.y = cvt_pk_bf16(v0[2], v0[3]); w.z = cvt_pk_bf16(v1[0], v1[1]); w.w = cvt_pk_bf16(v1[2], v1[3]);
                        *(u32x4*)(MG + ro + bj * HALF) = w; } }
        } else if constexpr (mode == E_GLU) {
            bf16_t* O = (bf16_t*)(ws + WS_SGLU);
#pragma unroll
            for (int ai = 0; ai < 2; ++ai)
#pragma unroll
                for (int m = 0; m < 4; ++m) { bf16_t* rowp = O + (size_t)(row0 + ai * HALF + m * 16) * SW + u.pn * HALF + cb;
                    f32x4 v0, v1;
#pragma unroll
                    for (int j = 0; j < 4; ++j) { v0[j] = acc[ai][0][m][0][j] * sigmoidf_(acc[ai][1][m][0][j]); v1[j] = acc[ai][0][m][1][j] * sigmoidf_(acc[ai][1][m][1][j]); }
                    u32x4 w; w.x = cvt_pk_bf16(v0[0], v0[1]); w.y = cvt_pk_bf16(v0[2], v0[3]); w.z = cvt_pk_bf16(v1[0], v1[1]); w.w = cvt_pk_bf16(v1[2], v1[3]);
                    *(u32x4*)rowp = w; }
        } else if constexpr (mode == E_S5A) {
            float* O = (float*)(ws + WS_SLOC); const int g = u.pn, rg0 = (u.pm - 5 * g) * BM + wr * 64 + fr;
#pragma unroll
            for (int ai = 0; ai < 2; ++ai)
#pragma unroll
                for (int m = 0; m < 4; ++m) { float* rowp = O + ((size_t)g * S5ROWS + rg0 + ai * HALF + m * 16) * 256 + cb;
#pragma unroll
                    for (int bj = 0; bj < 2; ++bj)
#pragma unroll
                        for (int n = 0; n < 2; ++n) *(f32x4*)(rowp + bj * HALF + 4 * n) = acc[ai][bj][m][n]; }
        } else if constexpr (mode == E_S5C) {
            bf16_t* O = (bf16_t*)(ws + WS_SACT); const int g = u.pn, rg0 = (u.pm - 5 * g) * BM + wr * 64 + fr;
#pragma unroll
            for (int ai = 0; ai < 2; ++ai)
#pragma unroll
                for (int m = 0; m < 4; ++m) { const int rg = rg0 + ai * HALF + m * 16, b = rg >> 7, ch = rg & 127;
#pragma unroll
                    for (int bj = 0; bj < 2; ++bj) { const int t = 8 * bj + 2 * wc + (fq >> 1); const int token = b * SEQ + ch * 16 + t;
                        const f32x4 v0 = acc[ai][bj][m][0], v1 = acc[ai][bj][m][1];
                        u32x4 w; w.x = cvt_pk_bf16(gelu_tanh(v0[0]), gelu_tanh(v0[1])); w.y = cvt_pk_bf16(gelu_tanh(v0[2]), gelu_tanh(v0[3]));
                        w.z = cvt_pk_bf16(gelu_tanh(v1[0]), gelu_tanh(v1[1])); w.w = cvt_pk_bf16(gelu_tanh(v1[2]), gelu_tanh(v1[3]));
                        *(u32x4*)(O + (size_t)token * SW + g * 16 + 8 * (fq & 1)) = w; } }
        } else {
            const int pn = u.pn;
            if (pn <= 4) {
                const bool isq = pn < 4, lat = u.pm < 64;
                const float* rope = (const float*)(ws + WS_ROPE);
                const int f0 = 16 * (wc & 1) + 4 * fq;
#pragma unroll
                for (int ai = 0; ai < 2; ++ai)
#pragma unroll
                    for (int m = 0; m < 4; ++m) { const int r = row0 + ai * HALF + m * 16;
                        f32x4 c0 = {1.f, 0.f, 1.f, 0.f}, c1 = {1.f, 0.f, 1.f, 0.f};
                        size_t orow;
                        if (lat) { const int l = r & (SEQ - 1); const int posv = (wc < 2) ? (l >> 6) : (l & 63);
                            const float* rp = rope + (size_t)(posv * 32 + f0) * 2; c0 = *(const f32x4*)rp; c1 = *(const f32x4*)(rp + 4);
                            orow = isq ? (size_t)r : (size_t)((r >> 11) * KROWS + l); }
                        else { const int rc = r - MLAT; orow = (size_t)((rc >> 8) * KROWS + SEQ + (rc & 255)); }
                        const float sc = isq ? QSCALE : 1.f;
#pragma unroll
                        for (int bj = 0; bj < 2; ++bj) { const f32x4 a0 = acc[ai][bj][m][0], a1 = acc[ai][bj][m][1];
                            const float o0 = (a0[0] * c0[0] - a0[1] * c0[1]) * sc, o1 = (a0[1] * c0[0] + a0[0] * c0[1]) * sc;
                            const float o2 = (a0[2] * c0[2] - a0[3] * c0[3]) * sc, o3 = (a0[3] * c0[2] + a0[2] * c0[3]) * sc;
                            const float o4 = (a1[0] * c1[0] - a1[1] * c1[1]) * sc, o5 = (a1[1] * c1[0] + a1[0] * c1[1]) * sc;
                            const float o6 = (a1[2] * c1[2] - a1[3] * c1[3]) * sc, o7 = (a1[3] * c1[2] + a1[2] * c1[3]) * sc;
                            u32x4 w; w.x = cvt_pk_bf16(o0, o1); w.y = cvt_pk_bf16(o2, o3); w.z = cvt_pk_bf16(o4, o5); w.w = cvt_pk_bf16(o6, o7);
                            bf16_t* dst = isq ? (bf16_t*)(ws + WS_QB) + orow * QW + pn * BM + bj * HALF + cb
                                              : (bf16_t*)(ws + WS_KB) + orow * 256 + bj * HALF + cb;
                            *(u32x4*)dst = w; } }
            } else if (pn == 5) {
                bf16_t* VT = (bf16_t*)(ws + WS_VT);
#pragma unroll
                for (int ai = 0; ai < 2; ++ai)
#pragma unroll
                    for (int m = 0; m < 4; ++m) { const int r = row0 + ai * HALF + m * 16; int b, key;
                        if (u.pm < 64) { b = r >> 11; key = r & (SEQ - 1); } else { const int rc = r - MLAT; b = rc >> 8; key = SEQ + (rc & 255); }
#pragma unroll
                        for (int bj = 0; bj < 2; ++bj) { bf16_t* dst = VT + ((size_t)(b * 2 + bj) * HD + cb) * KROWS + key;
#pragma unroll
                            for (int n = 0; n < 2; ++n)
#pragma unroll
                                for (int j = 0; j < 4; ++j) dst[(size_t)(4 * n + j) * KROWS] = (bf16_t)f2bf(acc[ai][bj][m][n][j]); } }
            } else if (pn <= 7) {
                bf16_t* U = (bf16_t*)(ws + WS_U);
#pragma unroll
                for (int ai = 0; ai < 2; ++ai)
#pragma unroll
                    for (int m = 0; m < 4; ++m) { const int r = row0 + ai * HALF + m * 16; int urow, t;
                        if (u.pm < 64) { const int l = r & (SEQ - 1); urow = (r >> 11) * 128 + (l >> 4); t = l & 15; }
                        else { const int rc = r - MLAT; urow = 1024 + (rc >> 8) * 16 + ((rc & 255) >> 4); t = rc & 15; }
#pragma unroll
                        for (int bj = 0; bj < 2; ++bj) { const int g = (pn - 6) * 16 + 8 * bj + 2 * wc + (fq >> 1);
                            const f32x4 v0 = acc[ai][bj][m][0], v1 = acc[ai][bj][m][1];
                            u32x4 w; w.x = cvt_pk_bf16(v0[0], v0[1]); w.y = cvt_pk_bf16(v0[2], v0[3]); w.z = cvt_pk_bf16(v1[0], v1[1]); w.w = cvt_pk_bf16(v1[2], v1[3]);
                            *(u32x4*)(U + ((size_t)g * S5ROWS + urow) * 512 + t * 16 + 8 * (fq & 1)) = w; } }
            } else {
                const bool isa = pn < 16; bf16_t* SG = (bf16_t*)(ws + (isa ? WS_SGA : WS_SGS)); const int ct = (pn - (isa ? 8 : 16)) * BM + cb;
#pragma unroll
                for (int ai = 0; ai < 2; ++ai)
#pragma unroll
                    for (int m = 0; m < 4; ++m) { bf16_t* rowp = SG + (size_t)(row0 + ai * HALF + m * 16) * DM + ct;
#pragma unroll
                        for (int bj = 0; bj < 2; ++bj) { const f32x4 v0 = acc[ai][bj][m][0], v1 = acc[ai][bj][m][1];
                            u32x4 w; w.x = cvt_pk_bf16(sigmoidf_(v0[0]), sigmoidf_(v0[1])); w.y = cvt_pk_bf16(sigmoidf_(v0[2]), sigmoidf_(v0[3]));
                            w.z = cvt_pk_bf16(sigmoidf_(v1[0]), sigmoidf_(v1[1])); w.w = cvt_pk_bf16(sigmoidf_(v1[2]), sigmoidf_(v1[3]));
                            *(u32x4*)(rowp + bj * HALF) = w; } }
            }
        }
    }
};

template <int MODE> __device__ __forceinline__ void gemm_phase(LAS unsigned char* lds, const Gemm g, const Order& S, const Epi<MODE>& E, int tid) {
    const int wid = __builtin_amdgcn_readfirstlane(tid >> 6), lane = tid & 63, wr = wid >> 2, wc = wid & 3, fr = lane & 15, fq = lane >> 4;
    const int K = g.K, nt = K / BK;
    unsigned voffA[2], voffB[2];
#pragma unroll
    for (int i = 0; i < 2; ++i) { int R, C; stage_rc(tid * 16 + i * 8192, R, C); const int Rb = (R & ~31) + perm32(R & 31);
        voffA[i] = (unsigned)(R * g.lda + C) * 2u; voffB[i] = (unsigned)(Rb * g.ldb + C) * 2u; }
    const size_t kstep = (size_t)(BK * 2);
    const size_t hstepA = (size_t)HALF * g.lda * 2, hstepB = (size_t)HALF * g.ldb * 2;
    const size_t tstepA = 2 * hstepA, tstepB = 2 * hstepB;
    const unsigned ldsw = (unsigned)wid * 1024u;
    const int aoff = lds_byte(wr * 64 + fr, fq * 8), boff = lds_byte(wc * 32 + fr, fq * 8);
#define PG8_SA(b, h) (((b) * 2 + (h)) * HTB)
#define PG8_SB(b, h) ((4 + (b) * 2 + (h)) * HTB)
#define PG8_STAGE(bufoff, gbase, voff) do { _Pragma("unroll") for (int _i = 0; _i < 2; ++_i) \
        __builtin_amdgcn_global_load_lds((const unsigned*)((const char*)(gbase) + (voff)[_i]), (LAS unsigned*)(lds + (bufoff) + ldsw + _i * 8192), 16, 0, 0); } while (0)
#define PG8_LDA(dst, b, h) do { _Pragma("unroll") for (int m = 0; m < 4; ++m) _Pragma("unroll") for (int k = 0; k < 2; ++k) dst[m][k] = *(const LAS bf16x8*)(lds + PG8_SA(b, h) + aoff + m * 2048 + k * 1024); } while (0)
#define PG8_LDB(dst, b, h) do { _Pragma("unroll") for (int n = 0; n < 2; ++n) _Pragma("unroll") for (int k = 0; k < 2; ++k) dst[n][k] = *(const LAS bf16x8*)(lds + PG8_SB(b, h) + boff + n * 2048 + k * 1024); } while (0)
#define PG8_MMA(ai, bj, At, Bt) do { __builtin_amdgcn_s_setprio(1); _Pragma("unroll") for (int m = 0; m < 4; ++m) _Pragma("unroll") for (int n = 0; n < 2; ++n) _Pragma("unroll") for (int k = 0; k < 2; ++k) \
        acc[ai][bj][m][n] = __builtin_amdgcn_mfma_f32_16x16x32_bf16(Bt[n][k], At[m][k], acc[ai][bj][m][n], 0, 0, 0); __builtin_amdgcn_s_setprio(0); } while (0)
#define PG8_WAIT_V(n) asm volatile("s_waitcnt vmcnt(" #n ")" ::: "memory")
#define PG8_WAIT_L(n) asm volatile("s_waitcnt lgkmcnt(" #n ")" ::: "memory")
#define PG8_BAR __builtin_amdgcn_s_barrier()
#define PG8_SCHED __builtin_amdgcn_sched_barrier(0)
    Unit cur, nxt; int ui = 0;
    if (!S.next(0, cur)) return;
    f32x4 acc[2][2][4][2];
#pragma unroll
    for (int a = 0; a < 2; ++a)
#pragma unroll
        for (int b = 0; b < 2; ++b)
#pragma unroll
            for (int m = 0; m < 4; ++m)
#pragma unroll
                for (int n = 0; n < 2; ++n) acc[a][b][m][n] = (f32x4){0.f, 0.f, 0.f, 0.f};
    bf16x8 At[4][2], B0[2][2], B1[2][2];
    const char* cA = (const char*)g.A + (size_t)cur.pm * tstepA; const char* cB = (const char*)g.Bt + (size_t)cur.pn * tstepB;
    PG8_STAGE(PG8_SB(0, 0), cB, voffB); PG8_STAGE(PG8_SB(0, 1), cB + hstepB, voffB); PG8_STAGE(PG8_SA(0, 0), cA, voffA); PG8_STAGE(PG8_SA(0, 1), cA + hstepA, voffA);
    if (wr == 1) PG8_BAR;
    PG8_WAIT_V(2); PG8_BAR;
    PG8_STAGE(PG8_SB(1, 0), cB + kstep, voffB); PG8_STAGE(PG8_SA(1, 0), cA + kstep, voffA); PG8_STAGE(PG8_SB(1, 1), cB + hstepB + kstep, voffB);
    PG8_WAIT_V(6); PG8_BAR;
    for (;;) {
        const bool has_next = S.next(ui + 1, nxt);
        const char* nA = has_next ? (const char*)g.A + (size_t)nxt.pm * tstepA : cA; const char* nB = has_next ? (const char*)g.Bt + (size_t)nxt.pn * tstepB : cB;
        for (int t = 0; t < nt; t += 2) {
            const bool last = (t == nt - 2);
            const char* a1 = cA + (size_t)(t + 1) * kstep;
            const char* a2 = last ? nA : cA + (size_t)(t + 2) * kstep; const char* b2 = last ? nB : cB + (size_t)(t + 2) * kstep;
            const char* a3 = a2 + kstep; const char* b3 = b2 + kstep;
            PG8_LDB(B0, 0, 0); PG8_LDB(B1, 0, 1); PG8_SCHED; PG8_LDA(At, 0, 0); PG8_STAGE(PG8_SA(1, 1), a1 + hstepA, voffA);
            PG8_WAIT_V(8); PG8_WAIT_L(0); PG8_BAR; PG8_MMA(0, 0, At, B0); PG8_MMA(0, 1, At, B1); PG8_BAR; PG8_SCHED;
            PG8_LDA(At, 0, 1); PG8_STAGE(PG8_SB(0, 0), b2, voffB); PG8_STAGE(PG8_SB(0, 1), b2 + hstepB, voffB); PG8_STAGE(PG8_SA(0, 0), a2, voffA);
            PG8_WAIT_V(8); PG8_WAIT_L(0); PG8_BAR; PG8_MMA(1, 0, At, B0); PG8_MMA(1, 1, At, B1); PG8_BAR; PG8_SCHED;
            PG8_LDB(B0, 1, 0); PG8_LDB(B1, 1, 1); PG8_SCHED; PG8_LDA(At, 1, 0); PG8_STAGE(PG8_SA(0, 1), a2 + hstepA, voffA);
            PG8_WAIT_V(8); PG8_WAIT_L(0); PG8_BAR; PG8_MMA(0, 0, At, B0); PG8_MMA(0, 1, At, B1); PG8_BAR; PG8_SCHED;
            PG8_LDA(At, 1, 1); PG8_STAGE(PG8_SB(1, 0), b3, voffB); PG8_STAGE(PG8_SB(1, 1), b3 + hstepB, voffB); PG8_STAGE(PG8_SA(1, 0), a3, voffA);
            PG8_WAIT_V(8); PG8_WAIT_L(0); PG8_BAR; PG8_MMA(1, 0, At, B0); PG8_MMA(1, 1, At, B1); PG8_BAR; PG8_SCHED;
        }
        if (wr == 0) PG8_BAR;
        { const int l2 = lane_id(); E(acc, cur, wr, wc, l2 & 15, l2 >> 4); }
        if (!has_next) break;
#pragma unroll
        for (int a = 0; a < 2; ++a)
#pragma unroll
            for (int b = 0; b < 2; ++b)
#pragma unroll
                for (int m = 0; m < 4; ++m)
#pragma unroll
                    for (int n = 0; n < 2; ++n) acc[a][b][m][n] = (f32x4){0.f, 0.f, 0.f, 0.f};
        cur = nxt; cA = nA; cB = nB; ++ui;
        if (wr == 1) PG8_BAR;
    }
    PG8_WAIT_V(0);
    PG8_BAR;
#undef PG8_SA
#undef PG8_SB
#undef PG8_STAGE
#undef PG8_LDA
#undef PG8_LDB
#undef PG8_MMA
#undef PG8_WAIT_V
#undef PG8_WAIT_L
#undef PG8_BAR
#undef PG8_SCHED
}

__device__ __forceinline__ int src_col(int mode, int n) {
    if (mode == 1) { if (n >= 1280) return n; const int pos = n & 127, mm = pos >> 1, sec = pos & 1; const int i = mm + ((mm >= 32) ? 32 : 0); return (n & ~127) + i + 32 * sec; }
    if (mode == 2) { const int t = n >> 8, w = n & 255; return (w < 128) ? t * 128 + w : 512 + t * 128 + (w - 128); }
    return n;
}
__device__ __forceinline__ void p0_transpose_item(const float* W, int K, int N, bf16_t* WT, int mode, LAS float* scr, int item, int lane) {
    const int nblk = N / 32, kb = item / nblk, nb = item % nblk, k0 = 64 * kb, n0 = 32 * nb;
    const int sc = src_col(mode, n0 + (lane & 31));
#pragma unroll 8
    for (int i = 0; i < 32; ++i) { const int kk = 2 * i + (lane >> 5); scr[kk * 33 + (lane & 31)] = W[(size_t)(k0 + kk) * N + sc]; }
    LDS_WAIT(); asm volatile("" ::: "memory");
    const int c = lane & 7;
#pragma unroll
    for (int j = 0; j < 4; ++j) { const int n = (lane >> 3) + 8 * j; const LAS float* s = scr + (8 * c) * 33 + n;
        u32x4 o; o.x = pk2(s[0 * 33], s[1 * 33]); o.y = pk2(s[2 * 33], s[3 * 33]); o.z = pk2(s[4 * 33], s[5 * 33]); o.w = pk2(s[6 * 33], s[7 * 33]);
        *(u32x4*)(WT + (size_t)(n0 + n) * K + k0 + 8 * c) = o; }
    LDS_WAIT(); asm volatile("" ::: "memory");
}

__device__ __forceinline__ void ada_item(LAS unsigned char* lds, int item, int tid) {
    LAS float* scv = (LAS float*)lds;
    LAS float* red = (LAS float*)(lds + 73728);
    for (int i = tid; i < 9 * DM; i += 512) { const float v = (i < 8 * DM) ? KP->in[1][i] : KP->in[3][i - 8 * DM]; scv[i] = v / (1.f + __expf(-v)); }
    __syncthreads();
    const int cl = tid & 15, kg = tid >> 4, n0 = item * 64;
    const float* w = KP->in[4] + (size_t)(kg * 64) * 12288 + n0 + 4 * cl;
    f32x4 a[9];
#pragma unroll
    for (int m = 0; m < 9; ++m) a[m] = (f32x4){0.f, 0.f, 0.f, 0.f};
#pragma unroll 4
    for (int k = 0; k < 64; ++k) { const f32x4 wv = *(const f32x4*)(w + (size_t)k * 12288);
#pragma unroll
        for (int m = 0; m < 9; ++m) a[m] += wv * scv[m * DM + kg * 64 + k]; }
#pragma unroll
    for (int m = 0; m < 9; ++m) *(LAS f32x4*)(red + (kg * 9 + m) * 64 + 4 * cl) = a[m];
    __syncthreads();
    float* MOD = (float*)(KP->ws + WS_MOD);
    for (int i = tid; i < 9 * 64; i += 512) { const int m = i >> 6, col = i & 63; float s = KP->in[5][n0 + col];
        for (int q = 0; q < 32; ++q) s += red[(q * 9 + m) * 64 + col];
        MOD[(size_t)m * 12288 + n0 + col] = s; }
    __syncthreads();
}

__device__ __forceinline__ void s5_precompute(LAS unsigned char* lds, int g, int tid) {
    LAS float* Ere = (LAS float*)lds;
    LAS float* Eim = Ere + 2176;
    LAS float* Bre = Eim + 2176;
    LAS float* Bim = Bre + 2048;
    LAS float* Cre = Bim + 2048;
    LAS float* Cim = Cre + 2048;
    LAS float* Cf = Cim + 2048;
    float* LAMT = (float*)(KP->ws + WS_LAMT);
    if (tid < 128) {
        const int dir = tid >> 6, pp = tid & 63;
        const float are = KP->in[8][(dir * 32 + g) * 64 + pp], aim = KP->in[9][(dir * 32 + g) * 64 + pp];
        const float dt = expf(KP->in[10][dir * 32 + g]);
        const float mag = expf(are * dt); float sn, cs; sincosf(aim * dt, &sn, &cs);
        const float lr = mag * cs, li = mag * sn;
        const float nr = lr - 1.f, ni = li, den = are * are + aim * aim;
        Cf[tid * 2] = (nr * are + ni * aim) / den; Cf[tid * 2 + 1] = (ni * are - nr * aim) / den;
        float er = 1.f, ei = 0.f;
        for (int d = 0; d <= 16; ++d) { Ere[tid * 17 + d] = er; Eim[tid * 17 + d] = ei;
            if (d == 16) { LAMT[((g * 2 + dir) * 2 + 0) * 64 + pp] = er; LAMT[((g * 2 + dir) * 2 + 1) * 64 + pp] = ei; }
            const float t = er * lr - ei * li; ei = er * li + ei * lr; er = t; }
    }
    __syncthreads();
    for (int idx = tid; idx < 2048; idx += 512) { const int dir = idx >> 10, pp = (idx >> 4) & 63, h = idx & 15;
        const size_t si = ((size_t)(dir * 32 + g) * 64 + pp) * 16 + h; const float br = KP->in[11][si], bi = KP->in[12][si];
        const float cr = Cf[(dir * 64 + pp) * 2], ci = Cf[(dir * 64 + pp) * 2 + 1];
        Bre[idx] = cr * br - ci * bi; Bim[idx] = cr * bi + ci * br;
        const int hh = (idx >> 6) & 15, p2 = idx & 63; const size_t ci2 = ((size_t)(dir * 32 + g) * 16 + hh) * 64 + p2;
        Cre[idx] = KP->in[13][ci2]; Cim[idx] = KP->in[14][ci2]; }
    __syncthreads();
    bf16_t* Wm = (bf16_t*)(KP->ws + WS_WMAT) + (size_t)g * 256 * 256;
    bf16_t* Mm = (bf16_t*)(KP->ws + WS_MMAT) + (size_t)g * 256 * 512;
    for (int idx = tid; idx < 65536; idx += 512) {
        {
            const int n = idx >> 8, k = idx & 255, dir = n >> 7, ri = (n >> 6) & 1, pp = n & 63, j = k >> 4, hh = k & 15, e = dir ? j : 15 - j;
            const float er = Ere[(dir * 64 + pp) * 17 + e], ei = Eim[(dir * 64 + pp) * 17 + e], br = Bre[(dir * 64 + pp) * 16 + hh], bi = Bim[(dir * 64 + pp) * 16 + hh];
            Wm[idx] = (bf16_t)f2bf(ri ? (er * bi + ei * br) : (er * br - ei * bi));
        }
        {
            const int row = idx >> 8, t = row >> 4, hh = row & 15, cc = idx & 255, dir = cc >> 7, ri = (cc >> 6) & 1, pp = cc & 63, e = dir ? 16 - t : t + 1;
            const float er = Ere[(dir * 64 + pp) * 17 + e], ei = Eim[(dir * 64 + pp) * 17 + e], cr = Cre[(dir * 16 + hh) * 64 + pp], ci = Cim[(dir * 16 + hh) * 64 + pp];
            Mm[(size_t)row * 512 + 256 + cc] = (bf16_t)f2bf(ri ? -(cr * ei + ci * er) : (cr * er - ci * ei));
        }
    }
    if (tid < 496) {
        const int dd = tid / 16 - 15, hh = tid & 15, e = dd < 0 ? -dd : dd;
        float kv[16];
#pragma unroll
        for (int q = 0; q < 16; ++q) kv[q] = 0.f;
#pragma unroll
        for (int dir = 0; dir < 2; ++dir) {
            const bool on = dir == 0 ? (dd >= 0) : (dd <= 0);
            if (on) {
                for (int pp = 0; pp < 64; ++pp) {
                    const float er = Ere[(dir * 64 + pp) * 17 + e], ei = Eim[(dir * 64 + pp) * 17 + e], cr = Cre[(dir * 16 + hh) * 64 + pp], ci = Cim[(dir * 16 + hh) * 64 + pp];
                    const float gr = cr * er - ci * ei, gi = cr * ei + ci * er;
#pragma unroll
                    for (int q = 0; q < 16; ++q) kv[q] += gr * Bre[(dir * 64 + pp) * 16 + q] - gi * Bim[(dir * 64 + pp) * 16 + q];
                }
            }
        }
        if (dd == 0) { const float dv = KP->in[15][g * 16 + hh];
#pragma unroll
            for (int q = 0; q < 16; ++q) kv[q] += (q == hh) ? dv : 0.f; }
        u32x4 w0, w1;
        w0.x = pk2(kv[0], kv[1]); w0.y = pk2(kv[2], kv[3]); w0.z = pk2(kv[4], kv[5]); w0.w = pk2(kv[6], kv[7]);
        w1.x = pk2(kv[8], kv[9]); w1.y = pk2(kv[10], kv[11]); w1.z = pk2(kv[12], kv[13]); w1.w = pk2(kv[14], kv[15]);
        for (int t = 0; t < 16; ++t) { const int j = t - dd; if (j >= 0 && j < 16) { bf16_t* dst = Mm + (size_t)(t * 16 + hh) * 512 + j * 16; *(u32x4*)dst = w0; *(u32x4*)(dst + 8) = w1; } }
    }
    __syncthreads();
}

__device__ __forceinline__ void step_prologue(LAS unsigned char* lds, int tid) {
    const int lane = tid & 63, wave = tid >> 6;
    for (int it = blockIdx.x; it < 225; it += gridDim.x) {
        if (it < 32) s5_precompute(lds, it, tid);
        else if (it < 224) ada_item(lds, it - 32, tid);
        else { float* rope = (float*)(KP->ws + WS_ROPE);
            for (int idx = tid; idx < 2048; idx += 512) { const int pos = idx >> 5, f = idx & 31; const float fr_ = powf(10000.f, -(float)f / 32.f); const float ang = (float)pos * fr_;
                rope[idx * 2] = cosf(ang); rope[idx * 2 + 1] = sinf(ang); } }
    }
    __syncthreads();
    LAS float* scr = (LAS float*)(lds + wave * 16384);
    const int gw = blockIdx.x * 8 + wave, NGW = gridDim.x * 8;
    constexpr int I_IN = 32 * 192, I_GLU = 8 * 32, I_AUP = 16 * 64, I_SUP = 8 * 64, I_OUT = 32 * 64, I_M1 = 32 * 256, I_M2 = 128 * 64;
    constexpr int NITEMS = I_IN + I_GLU + I_AUP + I_SUP + I_OUT + I_M1 + I_M2;
    unsigned char* ws = KP->ws;
    for (int it = gw; it < NITEMS; it += NGW) {
        int r = it;
        if (r < I_IN) { p0_transpose_item(KP->in[6], DM, INC, (bf16_t*)(ws + WS_WTIN), 1, scr, r, lane); continue; } r -= I_IN;
        if (r < I_GLU) { p0_transpose_item(KP->in[16], SW, 2 * SW, (bf16_t*)(ws + WS_WTGLU), 2, scr, r, lane); continue; } r -= I_GLU;
        if (r < I_AUP) { p0_transpose_item(KP->in[17], QW, DM, (bf16_t*)(ws + WS_WTAUP), 0, scr, r, lane); continue; } r -= I_AUP;
        if (r < I_SUP) { p0_transpose_item(KP->in[18], SW, DM, (bf16_t*)(ws + WS_WTSUP), 0, scr, r, lane); continue; } r -= I_SUP;
        if (r < I_OUT) { p0_transpose_item(KP->in[19], DM, DM, (bf16_t*)(ws + WS_WTOUT), 0, scr, r, lane); continue; } r -= I_OUT;
        if (r < I_M1) { p0_transpose_item(KP->in[22], DM, DFF, (bf16_t*)(ws + WS_WTM1), 0, scr, r, lane); continue; } r -= I_M1;
        p0_transpose_item(KP->in[24], DFF, DM, (bf16_t*)(ws + WS_WTM2), 0, scr, r, lane);
    }
}

__device__ __forceinline__ void ln_stats(const f32x4 (&v)[8], float& mean, float& rstd) {
    float s = 0.f;
#pragma unroll
    for (int j = 0; j < 8; ++j) s += (v[j][0] + v[j][1]) + (v[j][2] + v[j][3]);
    mean = wave_sum(s) * (1.f / DM); float q = 0.f;
#pragma unroll
    for (int j = 0; j < 8; ++j) { const f32x4 d = v[j] - mean; q += (d[0] * d[0] + d[1] * d[1]) + (d[2] * d[2] + d[3] * d[3]); }
    rstd = rsqrtf(wave_sum(q) * (1.f / DM) + LN_EPS);
}
__device__ __forceinline__ void step_ln1(int tid) {
    const int lane = tid & 63, gw = blockIdx.x * 8 + (tid >> 6), NGW = gridDim.x * 8;
    const float* MOD = (const float*)(KP->ws + WS_MOD); bf16_t* H = (bf16_t*)(KP->ws + WS_HALL);
    for (int r = gw; r < MALL; r += NGW) {
        const float* src = (r < MLAT) ? KP->in[0] + (size_t)r * DM : KP->in[2] + (size_t)(r - MLAT) * DM;
        const float* md = MOD + (size_t)((r < MLAT) ? (r >> 11) : 8) * 12288;
        f32x4 v[8];
#pragma unroll
        for (int j = 0; j < 8; ++j) v[j] = *(const f32x4*)(src + 4 * (lane + 64 * j));
        float mean, rstd; ln_stats(v, mean, rstd);
#pragma unroll
        for (int j = 0; j < 8; ++j) { const int c = 4 * (lane + 64 * j); const f32x4 sh = *(const f32x4*)(md + c), sc = *(const f32x4*)(md + DM + c);
            const f32x4 o = (v[j] - mean) * rstd * (sc + 1.f) + sh;
            u32x2 w; w.x = cvt_pk_bf16(o[0], o[1]); w.y = cvt_pk_bf16(o[2], o[3]); *(u32x2*)(H + (size_t)r * DM + c) = w; }
    }
}
__device__ __forceinline__ void step_ln2(int tid) {
    const int lane = tid & 63, gw = blockIdx.x * 8 + (tid >> 6), NGW = gridDim.x * 8;
    const float* MOD = (const float*)(KP->ws + WS_MOD); bf16_t* H = (bf16_t*)(KP->ws + WS_H2);
    const float* lg = KP->in[20]; const float* lb = KP->in[21];
    for (int r = gw; r < MLAT; r += NGW) {
        float* row = KP->out + (size_t)r * DM; const float* md = MOD + (size_t)(r >> 11) * 12288;
        f32x4 v[8];
#pragma unroll
        for (int j = 0; j < 8; ++j) v[j] = *(const f32x4*)(row + 4 * (lane + 64 * j));
        float mean, rstd; ln_stats(v, mean, rstd);
#pragma unroll
        for (int j = 0; j < 8; ++j) { const int c = 4 * (lane + 64 * j); v[j] = (v[j] - mean) * rstd * *(const f32x4*)(lg + c) + *(const f32x4*)(lb + c); *(f32x4*)(row + c) = v[j]; }
        ln_stats(v, mean, rstd);
#pragma unroll
        for (int j = 0; j < 8; ++j) { const int c = 4 * (lane + 64 * j); const f32x4 sh = *(const f32x4*)(md + 3 * DM + c), sc = *(const f32x4*)(md + 4 * DM + c);
            const f32x4 o = (v[j] - mean) * rstd * (sc + 1.f) + sh;
            u32x2 w; w.x = cvt_pk_bf16(o[0], o[1]); w.y = cvt_pk_bf16(o[2], o[3]); *(u32x2*)(H + (size_t)r * DM + c) = w; }
    }
}
__device__ __forceinline__ void step_ln3(int tid) {
    const int lane = tid & 63, gw = blockIdx.x * 8 + (tid >> 6), NGW = gridDim.x * 8;
    const float* lg = KP->in[26]; const float* lb = KP->in[27];
    for (int r = gw; r < MLAT; r += NGW) {
        float* row = KP->out + (size_t)r * DM;
        f32x4 v[8];
#pragma unroll
        for (int j = 0; j < 8; ++j) v[j] = *(const f32x4*)(row + 4 * (lane + 64 * j));
        float mean, rstd; ln_stats(v, mean, rstd);
#pragma unroll
        for (int j = 0; j < 8; ++j) { const int c = 4 * (lane + 64 * j); *(f32x4*)(row + c) = (v[j] - mean) * rstd * *(const f32x4*)(lg + c) + *(const f32x4*)(lb + c); }
    }
}

constexpr int KS_PITCH = 272, VT_PITCH = 144, VT_OFF = 64 * KS_PITCH;
__device__ __forceinline__ void step_attn(LAS unsigned char* lds, int tid) {
    const int w = tid >> 6, lane = tid & 63, fr = lane & 15, fq = lane >> 4;
    const bf16_t* Qb = (const bf16_t*)(KP->ws + WS_QB); const bf16_t* Kb = (const bf16_t*)(KP->ws + WS_KB); const bf16_t* Vtg = (const bf16_t*)(KP->ws + WS_VT);
    bf16_t* AO = (bf16_t*)(KP->ws + WS_ATTN);
    for (int item = blockIdx.x; item < 512; item += gridDim.x) {
        const int hp = item & 1, n = (item >> 1) & 15, kvh = (item >> 5) & 1, b = item >> 6;
        const int head = kvh * 4 + hp * 2 + (w >> 2);
        const int q0 = n * 128 + (w & 3) * 32;
        bf16x8 qf[2][4];
#pragma unroll
        for (int qb = 0; qb < 2; ++qb)
#pragma unroll
            for (int ks = 0; ks < 4; ++ks) qf[qb][ks] = *(const bf16x8*)(Qb + (size_t)(b * SEQ + q0 + 16 * qb + fr) * QW + head * HD + 32 * ks + 8 * fq);
        const float sk = KP->in[7][head] * LOG2E;
        float m_[2] = {sk, sk}, l_[2]; l_[0] = l_[1] = (fq == 0) ? 1.f : 0.f;
        f32x4 o[2][8];
#pragma unroll
        for (int qb = 0; qb < 2; ++qb)
#pragma unroll
            for (int db = 0; db < 8; ++db) o[qb][db] = (f32x4){0.f, 0.f, 0.f, 0.f};
        const int tb_lo = (n == 0) ? 2 : 0, tb_hi = (n == 15) ? 4 : 6, nbt = tb_hi - tb_lo, ntile = nbt + 4;
        const bf16_t* kbase = Kb + (size_t)b * KROWS * 256 + kvh * HD;
        const bf16_t* vbase = Vtg + (size_t)(b * 2 + kvh) * HD * KROWS;
        u32x4 kr[2], vr[2];
        {   const int krow0 = 128 * (n - 1) + 64 * tb_lo;
#pragma unroll
            for (int i = 0; i < 2; ++i) { const int c = tid + 512 * i; kr[i] = *(const u32x4*)(kbase + (size_t)(krow0 + (c >> 4)) * 256 + (c & 15) * 8);
                vr[i] = *(const u32x4*)(vbase + (size_t)(c >> 3) * KROWS + krow0 + (c & 7) * 8); } }
        for (int t = 0; t < ntile; ++t) {
            __syncthreads();
#pragma unroll
            for (int i = 0; i < 2; ++i) { const int c = tid + 512 * i; *(LAS u32x4*)(lds + (c >> 4) * KS_PITCH + (c & 15) * 16) = kr[i];
                *(LAS u32x4*)(lds + VT_OFF + (c >> 3) * VT_PITCH + (c & 7) * 16) = vr[i]; }
            __syncthreads();
            const bool band = t < nbt;
            const int kp0 = band ? 128 * (n - 1) + 64 * (tb_lo + t) : 0;
            if (t + 1 < ntile) { const int t1 = t + 1; const int krow0 = (t1 < nbt) ? 128 * (n - 1) + 64 * (tb_lo + t1) : SEQ + 64 * (t1 - nbt);
#pragma unroll
                for (int i = 0; i < 2; ++i) { const int c = tid + 512 * i; kr[i] = *(const u32x4*)(kbase + (size_t)(krow0 + (c >> 4)) * 256 + (c & 15) * 8);
                    vr[i] = *(const u32x4*)(vbase + (size_t)(c >> 3) * KROWS + krow0 + (c & 7) * 8); } }
            if (band && (kp0 + 63 < q0 - 128 || kp0 > q0 + 31 + 128)) continue;
            f32x4 s[4][2];
#pragma unroll
            for (int kb = 0; kb < 4; ++kb)
#pragma unroll
                for (int qb = 0; qb < 2; ++qb) s[kb][qb] = (f32x4){0.f, 0.f, 0.f, 0.f};
#pragma unroll
            for (int kb = 0; kb < 4; ++kb)
#pragma unroll
                for (int ks = 0; ks < 4; ++ks) { const bf16x8 kf = *(const LAS bf16x8*)(lds + (16 * kb + fr) * KS_PITCH + (32 * ks + 8 * fq) * 2);
#pragma unroll
                    for (int qb = 0; qb < 2; ++qb) s[kb][qb] = __builtin_amdgcn_mfma_f32_16x16x32_bf16(kf, qf[qb][ks], s[kb][qb], 0, 0, 0); }
            if (band) {
#pragma unroll
                for (int kb = 0; kb < 4; ++kb)
#pragma unroll
                    for (int qb = 0; qb < 2; ++qb)
#pragma unroll
                        for (int r = 0; r < 4; ++r) { const int dq = (q0 + 16 * qb + fr) - (kp0 + 16 * kb + 4 * fq + r); if (dq > 128 || dq < -128) s[kb][qb][r] = -1e30f; }
            }
            bf16x8 pa[2][2];
#pragma unroll
            for (int qb = 0; qb < 2; ++qb) {
                float mx = s[0][qb][0];
#pragma unroll
                for (int kb = 0; kb < 4; ++kb)
#pragma unroll
                    for (int r = 0; r < 4; ++r) mx = fmaxf(mx, s[kb][qb][r]);
                mx = fmaxf(mx, __shfl_xor(mx, 16)); mx = fmaxf(mx, __shfl_xor(mx, 32));
                const float mn = fmaxf(m_[qb], mx), alpha = exp2f(m_[qb] - mn); m_[qb] = mn;
                float rs = 0.f;
#pragma unroll
                for (int kb = 0; kb < 4; ++kb)
#pragma unroll
                    for (int r = 0; r < 4; ++r) { const float pv = exp2f(s[kb][qb][r] - mn); rs += pv; s[kb][qb][r] = pv; }
                l_[qb] = l_[qb] * alpha + rs;
#pragma unroll
                for (int r = 0; r < 4; ++r) { const float ar = __shfl(alpha, 4 * fq + r);
#pragma unroll
                    for (int db = 0; db < 8; ++db) o[qb][db][r] *= ar; }
#pragma unroll
                for (int kk = 0; kk < 2; ++kk) { u32x4 w4; w4.x = cvt_pk_bf16(s[2 * kk][qb][0], s[2 * kk][qb][1]); w4.y = cvt_pk_bf16(s[2 * kk][qb][2], s[2 * kk][qb][3]);
                    w4.z = cvt_pk_bf16(s[2 * kk + 1][qb][0], s[2 * kk + 1][qb][1]); w4.w = cvt_pk_bf16(s[2 * kk + 1][qb][2], s[2 * kk + 1][qb][3]);
                    pa[qb][kk] = __builtin_bit_cast(bf16x8, w4); }
            }
#pragma unroll
            for (int kk = 0; kk < 2; ++kk)
#pragma unroll
                for (int db = 0; db < 8; ++db) { const LAS unsigned char* vp = lds + VT_OFF + (16 * db + fr) * VT_PITCH + (32 * kk + 4 * fq) * 2;
                    const u32x2 lo = *(const LAS u32x2*)vp, hi = *(const LAS u32x2*)(vp + 32);
                    u32x4 v4; v4.x = lo.x; v4.y = lo.y; v4.z = hi.x; v4.w = hi.y; const bf16x8 vf = __builtin_bit_cast(bf16x8, v4);
#pragma unroll
                    for (int qb = 0; qb < 2; ++qb) o[qb][db] = __builtin_amdgcn_mfma_f32_16x16x32_bf16(pa[qb][kk], vf, o[qb][db], 0, 0, 0); }
        }
#pragma unroll
        for (int qb = 0; qb < 2; ++qb) { float lt = l_[qb]; lt += __shfl_xor(lt, 16); lt += __shfl_xor(lt, 32); const float inv = 1.f / lt;
#pragma unroll
            for (int r = 0; r < 4; ++r) { const float ir = __shfl(inv, 4 * fq + r); bf16_t* dst = AO + (size_t)(b * SEQ + q0 + 16 * qb + 4 * fq + r) * QW + head * HD + fr;
#pragma unroll
                for (int db = 0; db < 8; ++db) dst[16 * db] = (bf16_t)f2bf(o[qb][db][r] * ir); } }
    }
    __syncthreads();
}

__device__ __forceinline__ void step_scan(int tid) {
    if (tid >= 128) return;
    const int idx = blockIdx.x * 128 + tid; if (idx >= 32768) return;
    const int pp = idx & 63, dir = (idx >> 6) & 1, b = (idx >> 7) & 7, g = idx >> 10;
    const float* LAMT = (const float*)(KP->ws + WS_LAMT);
    const float lr = LAMT[((g * 2 + dir) * 2 + 0) * 64 + pp], li = LAMT[((g * 2 + dir) * 2 + 1) * 64 + pp];
    const float* SL = (const float*)(KP->ws + WS_SLOC) + (size_t)g * S5ROWS * 256 + dir * 128 + pp;
    bf16_t* U = (bf16_t*)(KP->ws + WS_U) + (size_t)g * S5ROWS * 512 + 256 + dir * 128 + pp;
    float sr = 0.f, si = 0.f;
    for (int c0 = 0; c0 < 144; c0 += 16) {
        float xr[16], xi[16];
#pragma unroll
        for (int q = 0; q < 16; ++q) { const int s = c0 + q; int row;
            if (s < 16) row = 1024 + b * 16 + (dir ? 15 - s : s); else row = b * 128 + (dir ? 127 - (s - 16) : (s - 16));
            xr[q] = SL[(size_t)row * 256]; xi[q] = SL[(size_t)row * 256 + 64]; }
#pragma unroll
        for (int q = 0; q < 16; ++q) { const int s = c0 + q;
            if (s >= 16) { const int row = b * 128 + (dir ? 127 - (s - 16) : (s - 16)); U[(size_t)row * 512] = (bf16_t)f2bf(sr); U[(size_t)row * 512 + 64] = (bf16_t)f2bf(si); }
            const float t = lr * sr - li * si + xr[q]; si = lr * si + li * sr + xi[q]; sr = t; }
    }
}

__global__ void __launch_bounds__(512, 2) fwd_kernel(Params p) {
    __builtin_assume(__builtin_amdgcn_workitem_id_y() == 0); __builtin_assume(__builtin_amdgcn_workitem_id_z() == 0);
    extern __shared__ __attribute__((aligned(16))) unsigned char lds_raw[];
    LAS unsigned char* lds = (LAS unsigned char*)lds_raw;
    unsigned char* ws = KP->ws;
    const int G = gridDim.x, c = blockIdx.x, lo = KP->lo, hi = KP->hi;
    const int wave_ = __builtin_amdgcn_readfirstlane(threadIdx.x >> 6);
#define TID (wave_ * 64 + lane_id())
#define IN(k) (lo <= (k) && (k) < hi)
#define SEAM(k) do { if (IN(k) && IN((k) + 1)) cg::this_grid().sync(); } while (0)
#define LSEAM(k) do { if (IN(k) && IN((k) + 1)) __syncthreads(); } while (0)
#define GEMM_STEP(k, MODE, Aoff, Boff, LDA, LDB, KK, OM, NM_, NN_, NWG, PA, PB, OUTP) \
    if (IN(k)) { const Gemm g{(const bf16_t*)(ws + (Aoff)), (const bf16_t*)(ws + (Boff)), LDA, LDB, KK}; const Order S{OM, NM_, NN_, NWG, G, c}; \
        const Epi<MODE> E{ws, PA, PB, OUTP}; gemm_phase<MODE>(lds, g, S, E, TID); }
    if (IN(0)) step_prologue(lds, TID);
    SEAM(0);
    if (IN(1)) step_ln1(TID);
    SEAM(1);
    GEMM_STEP(2, E_WIN, WS_HALL, WS_WTIN, DM, DM, DM, 1, 64, 24, 1568, nullptr, nullptr, nullptr)
    SEAM(2);
    if (IN(3)) step_attn(lds, TID);
    LSEAM(3);
    GEMM_STEP(4, E_S5A, WS_U, WS_WMAT, 512, 256, 256, 2, 5, 1, 160, nullptr, nullptr, nullptr)
    SEAM(4);
    if (IN(5)) step_scan(TID);
    SEAM(5);
    GEMM_STEP(6, E_S5C, WS_U, WS_MMAT, 512, 512, 512, 2, 4, 1, 128, nullptr, nullptr, nullptr)
    SEAM(6);
    GEMM_STEP(7, E_GLU, WS_SACT, WS_WTGLU, SW, SW, SW, 0, 64, 4, 256, nullptr, nullptr, nullptr)
    SEAM(7);
    GEMM_STEP(8, E_AUP, WS_ATTN, WS_WTAUP, QW, QW, QW, 0, 64, 8, 512, nullptr, nullptr, nullptr)
    LSEAM(8);
    GEMM_STEP(9, E_SUP, WS_SGLU, WS_WTSUP, SW, SW, SW, 0, 64, 8, 512, nullptr, nullptr, nullptr)
    SEAM(9);
    GEMM_STEP(10, E_WOUT, WS_MERG, WS_WTOUT, DM, DM, DM, 0, 64, 8, 512, KP->in[0], nullptr, KP->out)
    SEAM(10);
    if (IN(11)) step_ln2(TID);
    SEAM(11);
    GEMM_STEP(12, E_M1, WS_H2, WS_WTM1, DM, DM, DM, 0, 64, 32, 2048, KP->in[23], nullptr, nullptr)
    SEAM(12);
    GEMM_STEP(13, E_M2, WS_HID, WS_WTM2, DFF, DFF, DFF, 0, 64, 8, 512, KP->in[25], nullptr, KP->out)
    SEAM(13);
    if (IN(14)) step_ln3(TID);
#undef IN
#undef TID
#undef SEAM
#undef LSEAM
#undef GEMM_STEP
}

extern "C" void kernel_launch(void* const* d_in, const int* in_sizes, int n_in, void* d_out, int out_size, void* d_ws, size_t ws_size, hipStream_t stream) {
    static int grid = 0;
    if (grid == 0) {
        if (n_in != 28 || out_size != MLAT * DM || ws_size < WS_NEED) { fprintf(stderr, "kernel_launch: unexpected shapes (n_in %d out %d ws %zu)\n", n_in, out_size, ws_size); grid = -1; return; }
        int dev = 0, cus = 0, per_cu = 0;
        hipGetDevice(&dev); hipDeviceGetAttribute(&cus, hipDeviceAttributeMultiprocessorCount, dev);
        if (hipFuncSetAttribute((const void*)fwd_kernel, hipFuncAttributeMaxDynamicSharedMemorySize, LDS_BYTES) != hipSuccess) { fprintf(stderr, "kernel_launch: hipFuncSetAttribute failed\n"); grid = -1; return; }
        if (hipOccupancyMaxActiveBlocksPerMultiprocessor(&per_cu, (const void*)fwd_kernel, 512, LDS_BYTES) != hipSuccess || per_cu < 1) { fprintf(stderr, "kernel_launch: occupancy query gives %d\n", per_cu); (void)hipGetLastError(); per_cu = 1; }
        grid = cus;
        if (grid <= 0) grid = 256;
    }
    if (grid < 0) return;
    Params p{};
    for (int i = 0; i < 28; ++i) p.in[i] = (const float*)d_in[i];
    p.out = (float*)d_out; p.ws = (unsigned char*)d_ws;
#if N_LAUNCH_MODE == 1
    p.lo = 0; p.hi = NSTEPS;
    void* args[] = {&p};
    hipError_t e = hipLaunchCooperativeKernel((const void*)fwd_kernel, dim3(grid), dim3(512), args, LDS_BYTES, stream);
    if (e != hipSuccess) fprintf(stderr, "cooperative launch failed: %s (grid %d)\n", hipGetErrorString(e), grid);
#else
    for (int st = 0; st < NSTEPS; ++st) {
        p.lo = st; p.hi = st + 1;
        hipLaunchKernelGGL(fwd_kernel, dim3(grid), dim3(512), LDS_BYTES, stream, p);
    }
#endif
}
```

```cpp
#include <hip/hip_runtime.h>
#include <hip/hip_cooperative_groups.h>
#include <cstdio>
#include <cstdint>
namespace cg = cooperative_groups;

#ifndef N_LAUNCH_MODE
#define N_LAUNCH_MODE 1
#endif

#ifndef PROBE_MASK
#define PROBE_MASK 0
#endif
#define LAS __attribute__((address_space(3)))
typedef unsigned short bf16_t;
typedef short bf16x8 __attribute__((ext_vector_type(8)));
typedef float f32x4 __attribute__((ext_vector_type(4)));
typedef float f32x2 __attribute__((ext_vector_type(2)));
typedef unsigned u32x4 __attribute__((ext_vector_type(4)));
typedef unsigned u32x2 __attribute__((ext_vector_type(2)));

constexpr int DM = 2048, NB = 8, SEQ = 2048, CTXL = 256, HD = 128, NH = 8;
constexpr int QW = 1024, SW = 512, INC = 6144, DFF = 8192;
constexpr int MLAT = NB * SEQ, MCTX = NB * CTXL, MALL = MLAT + MCTX;
constexpr int KROWS = SEQ + CTXL;
constexpr int S5ROWS = 1280;
constexpr float ALPHA_F = 1.189207115002721f;
constexpr float LN_EPS = 1e-6f;
constexpr float LOG2E = 1.4426950408889634f;
constexpr float QSCALE = 0.08838834764831845f * LOG2E;
constexpr int NSTEPS = 15;

constexpr size_t MiB = 1u << 20;
constexpr size_t WS_WTIN = 1 * MiB, WS_WTGLU = 25 * MiB, WS_WTAUP = 26 * MiB, WS_WTSUP = 30 * MiB, WS_WTOUT = 32 * MiB, WS_WTM1 = 40 * MiB, WS_WTM2 = 72 * MiB;
constexpr size_t WS_WMAT = 104 * MiB, WS_MMAT = 108 * MiB, WS_MOD = 116 * MiB, WS_ROPE = 117 * MiB, WS_LAMT = 117 * MiB + 512 * 1024;
constexpr size_t WS_HALL = 128 * MiB;
constexpr size_t WS_ATTN = 128 * MiB;
constexpr size_t WS_SLOC = 160 * MiB;
constexpr size_t WS_QB = 200 * MiB, WS_KB = 232 * MiB, WS_VT = 241 * MiB;
constexpr size_t WS_SACT = 250 * MiB;
constexpr size_t WS_MERG = 200 * MiB;
constexpr size_t WS_U = 266 * MiB;
constexpr size_t WS_SGA = 306 * MiB, WS_SGS = 370 * MiB;
constexpr size_t WS_SGLU = 434 * MiB;
constexpr size_t WS_HID = 128 * MiB;
constexpr size_t WS_H2 = 384 * MiB;
constexpr size_t WS_NEED = 450 * MiB;

constexpr int LDS_BYTES = 147456;

struct Params { const float* in[28]; float* out; unsigned char* ws; int lo, hi; };
#define KP ((const __attribute__((address_space(4))) Params*)__builtin_amdgcn_kernarg_segment_ptr())
__device__ __forceinline__ int lane_id() { int l; asm volatile("v_mbcnt_lo_u32_b32 %0, -1, 0\n\tv_mbcnt_hi_u32_b32 %0, -1, %0" : "=v"(l)); return l; }

__device__ __forceinline__ unsigned f2bf(float f) { unsigned u = __builtin_bit_cast(unsigned, f); return (u + 0x7fffu + ((u >> 16) & 1u)) >> 16; }
__device__ __forceinline__ unsigned pk2(float lo, float hi) { return f2bf(lo) | (f2bf(hi) << 16); }
__device__ __forceinline__ unsigned cvt_pk_bf16(float lo, float hi) { unsigned r; asm volatile("v_cvt_pk_bf16_f32 %0, %1, %2" : "=v"(r) : "v"(lo), "v"(hi)); return r; }
__device__ __forceinline__ float bflo(unsigned w) { return __builtin_bit_cast(float, w << 16); }
__device__ __forceinline__ float bfhi(unsigned w) { return __builtin_bit_cast(float, w & 0xffff0000u); }
__device__ __forceinline__ float sigmoidf_(float x) { return 1.f / (1.f + __expf(-x)); }
__device__ __forceinline__ float gelu_tanh(float x) { const float u = 1.5957691216057308f * (x + 0.044715f * x * x * x); return x * sigmoidf_(u); }
__device__ __forceinline__ float wave_sum(float v) {
#pragma unroll
    for (int o = 1; o < 64; o <<= 1) v += __shfl_xor(v, o);
    return v;
}
#define LDS_WAIT() asm volatile("s_waitcnt lgkmcnt(0)" ::: "memory")

constexpr int BM = 256, BK = 64, HALF = 128, HTB = HALF * BK * 2;
__device__ __forceinline__ int lds_byte(int r, int c) { const int st = (r >> 4) * 2 + (c >> 5), rr = r & 15, cc = c & 31, ob = rr * 64 + cc * 2; return st * 1024 + (ob ^ (((ob >> 9) & 1) << 5)); }
__device__ __forceinline__ void stage_rc(int b, int& R, int& C) { const int st = b / 1024, sb = b % 1024, swz = sb ^ (((sb >> 9) & 1) << 5); R = (st >> 1) * 16 + swz / 64; C = (st & 1) * 32 + (swz % 64) / 2; }
__device__ __forceinline__ int perm32(int rho) { const int n = rho >> 4, i = rho & 15; return 8 * (i >> 2) + 4 * n + (i & 3); }

struct Unit { int pm, pn; };
struct Gemm { const bf16_t* A; const bf16_t* Bt; int lda, ldb, K; };
struct Order {
    int mode, nM, nN, nwg, G, c;
    __device__ __forceinline__ bool next(int i, Unit& u) const {
        const int L = i * G + c; if (L >= nwg) return false;
        if (mode == 2) { const int g = L / nM, ii = L - g * nM; u.pm = g * 5 + ii; u.pn = g; return true; }
        if (mode == 1 && L >= 1536) { const int t = L - 1536; u.pm = 64 + (t >> 2); u.pn = 4 + (t & 3); return true; }
        const int nw = nM * nN; int wgid = L; { const int q = nw / 8, r = nw % 8, xcd = wgid % 8, off = wgid / 8; wgid = (xcd < r ? xcd * (q + 1) : r * (q + 1) + (xcd - r) * q) + off; }
        const int nig = 8 * nN, gid = wgid / nig, fm = gid * 8, gsz = (nM - fm) < 8 ? (nM - fm) : 8;
        u.pm = fm + ((wgid % nig) % gsz); u.pn = (wgid % nig) / gsz; return true;
    }
};

enum EpiMode { E_WIN = 0, E_S5A, E_S5C, E_GLU, E_AUP, E_SUP, E_WOUT, E_M1, E_M2 };

template <int mode> struct Epi {
    unsigned char* ws; const float* pa; const float* pb; float* outp;
    __device__ __forceinline__ void operator()(const f32x4 (&acc)[2][2][4][2], const Unit& u, int wr, int wc, int fr, int fq) const {
        const int row0 = u.pm * BM + wr * 64 + fr;
        const int cb = wc * 32 + 8 * fq;
        if constexpr (mode == E_M1) {
            bf16_t* O = (bf16_t*)(ws + WS_HID); const float* b1 = pa;
            f32x4 bv[2][2];
#pragma unroll
            for (int bj = 0; bj < 2; ++bj)
#pragma unroll
                for (int n = 0; n < 2; ++n) bv[bj][n] = *(const f32x4*)(b1 + u.pn * BM + bj * HALF + cb + 4 * n);
#pragma unroll
            for (int ai = 0; ai < 2; ++ai)
#pragma unroll
                for (int m = 0; m < 4; ++m) { bf16_t* rowp = O + (size_t)(row0 + ai * HALF + m * 16) * DFF + u.pn * BM + cb;
#pragma unroll
                    for (int bj = 0; bj < 2; ++bj) { f32x4 v0 = acc[ai][bj][m][0] + bv[bj][0], v1 = acc[ai][bj][m][1] + bv[bj][1];
#pragma unroll
                        for (int j = 0; j < 4; ++j) { const float a = fmaxf(v0[j], 0.f), b = fmaxf(v1[j], 0.f); v0[j] = a * a; v1[j] = b * b; }
                        u32x4 w; w.x = cvt_pk_bf16(v0[0], v0[1]); w.y = cvt_pk_bf16(v0[2], v0[3]); w.z = cvt_pk_bf16(v1[0], v1[1]); w.w = cvt_pk_bf16(v1[2], v1[3]);
                        *(u32x4*)(rowp + bj * HALF) = w; } }
        } else if constexpr (mode == E_M2 || mode == E_WOUT) {
            const bool m2 = (mode == E_M2);
            const float* base = m2 ? (const float*)outp : pa; float* out = outp;
            const float* mod = (const float*)(ws + WS_MOD) + (size_t)(u.pm >> 3) * 12288 + (m2 ? 10240 : 4096);
            const float* b2 = pa;
            f32x4 gv[2][2], bv[2][2];
#pragma unroll
            for (int bj = 0; bj < 2; ++bj)
#pragma unroll
                for (int n = 0; n < 2; ++n) { const int c = u.pn * BM + bj * HALF + cb + 4 * n; gv[bj][n] = *(const f32x4*)(mod + c);
                    bv[bj][n] = m2 ? *(const f32x4*)(b2 + c) : (f32x4){0.f, 0.f, 0.f, 0.f}; }
#pragma unroll
            for (int ai = 0; ai < 2; ++ai)
#pragma unroll
                for (int m = 0; m < 4; ++m) { const size_t ro = (size_t)(row0 + ai * HALF + m * 16) * DM + u.pn * BM + cb;
#pragma unroll
                    for (int bj = 0; bj < 2; ++bj)
#pragma unroll
                        for (int n = 0; n < 2; ++n) { const f32x4 xb = *(const f32x4*)(base + ro + bj * HALF + 4 * n);
                            const f32x4 v = xb * ALPHA_F + gv[bj][n] * (acc[ai][bj][m][n] + bv[bj][n]);
                            *(f32x4*)(out + ro + bj * HALF + 4 * n) = v; } }
        } else if constexpr (mode == E_AUP || mode == E_SUP) {
            const bool sup = (mode == E_SUP);
            bf16_t* MG = (bf16_t*)(ws + WS_MERG); const bf16_t* SG = (const bf16_t*)(ws + (sup ? WS_SGS : WS_SGA));
#pragma unroll
            for (int ai = 0; ai < 2; ++ai)
#pragma unroll
                for (int m = 0; m < 4; ++m) { const size_t ro = (size_t)(row0 + ai * HALF + m * 16) * DM + u.pn * BM + cb;
#pragma unroll
                    for (int bj = 0; bj < 2; ++bj) { const u32x4 g = *(const u32x4*)(SG + ro + bj * HALF);
                        f32x4 v0 = acc[ai][bj][m][0], v1 = acc[ai][bj][m][1];
                        v0[0] *= bflo(g.x); v0[1] *= bfhi(g.x); v0[2] *= bflo(g.y); v0[3] *= bfhi(g.y);
                        v1[0] *= bflo(g.z); v1[1] *= bfhi(g.z); v1[2] *= bflo(g.w); v1[3] *= bfhi(g.w);
                        if (sup) { const u32x4 o = *(const u32x4*)(MG + ro + bj * HALF);
                            v0[0] += bflo(o.x); v0[1] += bfhi(o.x); v0[2] += bflo(o.y); v0[3] += bfhi(o.y);
                            v1[0] += bflo(o.z); v1[1] += bfhi(o.z); v1[2] += bflo(o.w); v1[3] += bfhi(o.w); }
                        u32x4 w; w.x = cvt_pk_bf16(v0[0], v0[1]); w.y = cvt_pk_bf16(v0[2], v0[3]); w.z = cvt_pk_bf16(v1[0], v1[1]); w.w = cvt_pk_bf16(v1[2], v1[3]);
                        *(u32x4*)(MG + ro + bj * HALF) = w; } }
        } else if constexpr (mode == E_GLU) {
            bf16_t* O = (bf16_t*)(ws + WS_SGLU);
#pragma unroll
            for (int ai = 0; ai < 2; ++ai)
#pragma unroll
                for (int m = 0; m < 4; ++m) { bf16_t* rowp = O + (size_t)(row0 + ai * HALF + m * 16) * SW + u.pn * HALF + cb;
                    f32x4 v0, v1;
#pragma unroll
                    for (int j = 0; j < 4; ++j) { v0[j] = acc[ai][0][m][0][j] * sigmoidf_(acc[ai][1][m][0][j]); v1[j] = acc[ai][0][m][1][j] * sigmoidf_(acc[ai][1][m][1][j]); }
                    u32x4 w; w.x = cvt_pk_bf16(v0[0], v0[1]); w.y = cvt_pk_bf16(v0[2], v0[3]); w.z = cvt_pk_bf16(v1[0], v1[1]); w.w = cvt_pk_bf16(v1[2], v1[3]);
                    *(u32x4*)rowp = w; }
        } else if constexpr (mode == E_S5A) {
            float* O = (float*)(ws + WS_SLOC); const int g = u.pn, rg0 = (u.pm - 5 * g) * BM + wr * 64 + fr;
#pragma unroll
            for (int ai = 0; ai < 2; ++ai)
#pragma unroll
                for (int m = 0; m < 4; ++m) { float* rowp = O + ((size_t)g * S5ROWS + rg0 + ai * HALF + m * 16) * 256 + cb;
#pragma unroll
                    for (int bj = 0; bj < 2; ++bj)
#pragma unroll
                        for (int n = 0; n < 2; ++n) *(f32x4*)(rowp + bj * HALF + 4 * n) = acc[ai][bj][m][n]; }
        } else if constexpr (mode == E_S5C) {
            bf16_t* O = (bf16_t*)(ws + WS_SACT); const int g = u.pn, rg0 = (u.pm - 5 * g) * BM + wr * 64 + fr;
#pragma unroll
            for (int ai = 0; ai < 2; ++ai)
#pragma unroll
                for (int m = 0; m < 4; ++m) { const int rg = rg0 + ai * HALF + m * 16, b = rg >> 7, ch = rg & 127;
#pragma unroll
                    for (int bj = 0; bj < 2; ++bj) { const int t = 8 * bj + 2 * wc + (fq >> 1); const int token = b * SEQ + ch * 16 + t;
                        const f32x4 v0 = acc[ai][bj][m][0], v1 = acc[ai][bj][m][1];
                        u32x4 w; w.x = cvt_pk_bf16(gelu_tanh(v0[0]), gelu_tanh(v0[1])); w.y = cvt_pk_bf16(gelu_tanh(v0[2]), gelu_tanh(v0[3]));
                        w.z = cvt_pk_bf16(gelu_tanh(v1[0]), gelu_tanh(v1[1])); w.w = cvt_pk_bf16(gelu_tanh(v1[2]), gelu_tanh(v1[3]));
                        *(u32x4*)(O + (size_t)token * SW + g * 16 + 8 * (fq & 1)) = w; } }
        } else {
            const int pn = u.pn;
            if (pn <= 4) {
                const bool isq = pn < 4, lat = u.pm < 64;
                const float* rope = (const float*)(ws + WS_ROPE);
                const int f0 = 16 * (wc & 1) + 4 * fq;
#pragma unroll
                for (int ai = 0; ai < 2; ++ai)
#pragma unroll
                    for (int m = 0; m < 4; ++m) { const int r = row0 + ai * HALF + m * 16;
                        f32x4 c0 = {1.f, 0.f, 1.f, 0.f}, c1 = {1.f, 0.f, 1.f, 0.f};
                        size_t orow;
                        if (lat) { const int l = r & (SEQ - 1); const int posv = (wc < 2) ? (l >> 6) : (l & 63);
                            const float* rp = rope + (size_t)(posv * 32 + f0) * 2; c0 = *(const f32x4*)rp; c1 = *(const f32x4*)(rp + 4);
                            orow = isq ? (size_t)r : (size_t)((r >> 11) * KROWS + l); }
                        else { const int rc = r - MLAT; orow = (size_t)((rc >> 8) * KROWS + SEQ + (rc & 255)); }
                        const float sc = isq ? QSCALE : 1.f;
#pragma unroll
                        for (int bj = 0; bj < 2; ++bj) { const f32x4 a0 = acc[ai][bj][m][0], a1 = acc[ai][bj][m][1];
                            const float o0 = (a0[0] * c0[0] - a0[1] * c0[1]) * sc, o1 = (a0[1] * c0[0] + a0[0] * c0[1]) * sc;
                            const float o2 = (a0[2] * c0[2] - a0[3] * c0[3]) * sc, o3 = (a0[3] * c0[2] + a0[2] * c0[3]) * sc;
                            const float o4 = (a1[0] * c1[0] - a1[1] * c1[1]) * sc, o5 = (a1[1] * c1[0] + a1[0] * c1[1]) * sc;
                            const float o6 = (a1[2] * c1[2] - a1[3] * c1[3]) * sc, o7 = (a1[3] * c1[2] + a1[2] * c1[3]) * sc;
                            u32x4 w; w.x = cvt_pk_bf16(o0, o1); w.y = cvt_pk_bf16(o2, o3); w.z = cvt_pk_bf16(o4, o5); w.w = cvt_pk_bf16(o6, o7);
                            bf16_t* dst = isq ? (bf16_t*)(ws + WS_QB) + orow * QW + pn * BM + bj * HALF + cb
                                              : (bf16_t*)(ws + WS_KB) + orow * 256 + bj * HALF + cb;
                            *(u32x4*)dst = w; } }
            } else if (pn == 5) {
                bf16_t* VT = (bf16_t*)(ws + WS_VT);
#pragma unroll
                for (int ai = 0; ai < 2; ++ai)
#pragma unroll
                    for (int m = 0; m < 4; ++m) { const int r = row0 + ai * HALF + m * 16; int b, key;
                        if (u.pm < 64) { b = r >> 11; key = r & (SEQ - 1); } else { const int rc = r - MLAT; b = rc >> 8; key = SEQ + (rc & 255); }
#pragma unroll
                        for (int bj = 0; bj < 2; ++bj) { bf16_t* dst = VT + ((size_t)(b * 2 + bj) * HD + cb) * KROWS + key;
#pragma unroll
                            for (int n = 0; n < 2; ++n)
#pragma unroll
                                for (int j = 0; j < 4; ++j) dst[(size_t)(4 * n + j) * KROWS] = (bf16_t)f2bf(acc[ai][bj][m][n][j]); } }
            } else if (pn <= 7) {
                bf16_t* U = (bf16_t*)(ws + WS_U);
#pragma unroll
                for (int ai = 0; ai < 2; ++ai)
#pragma unroll
                    for (int m = 0; m < 4; ++m) { const int r = row0 + ai * HALF + m * 16; int urow, t;
                        if (u.pm < 64) { const int l = r & (SEQ - 1); urow = (r >> 11) * 128 + (l >> 4); t = l & 15; }
                        else { const int rc = r - MLAT; urow = 1024 + (rc >> 8) * 16 + ((rc & 255) >> 4); t = rc & 15; }
#pragma unroll
                        for (int bj = 0; bj < 2; ++bj) { const int g = (pn - 6) * 16 + 8 * bj + 2 * wc + (fq >> 1);
                            const f32x4 v0 = acc[ai][bj][m][0], v1 = acc[ai][bj][m][1];
                            u32x4 w; w.x = cvt_pk_bf16(v0[0], v0[1]); w.y = cvt_pk_bf16(v0[2], v0[3]); w.z = cvt_pk_bf16(v1[0], v1[1]); w.w = cvt_pk_bf16(v1[2], v1[3]);
                            *(u32x4*)(U + ((size_t)g * S5ROWS + urow) * 512 + t * 16 + 8 * (fq & 1)) = w; } }
            } else {
                const bool isa = pn < 16; bf16_t* SG = (bf16_t*)(ws + (isa ? WS_SGA : WS_SGS)); const int ct = (pn - (isa ? 8 : 16)) * BM + cb;
#pragma unroll
                for (int ai = 0; ai < 2; ++ai)
#pragma unroll
                    for (int m = 0; m < 4; ++m) { bf16_t* rowp = SG + (size_t)(row0 + ai * HALF + m * 16) * DM + ct;
#pragma unroll
                        for (int bj = 0; bj < 2; ++bj) { const f32x4 v0 = acc[ai][bj][m][0], v1 = acc[ai][bj][m][1];
                            u32x4 w; w.x = cvt_pk_bf16(sigmoidf_(v0[0]), sigmoidf_(v0[1])); w.y = cvt_pk_bf16(sigmoidf_(v0[2]), sigmoidf_(v0[3]));
                            w.z = cvt_pk_bf16(sigmoidf_(v1[0]), sigmoidf_(v1[1])); w.w = cvt_pk_bf16(sigmoidf_(v1[2]), sigmoidf_(v1[3]));
                            *(u32x4*)(rowp + bj * HALF) = w; } }
            }
        }
    }
};

template <int MODE> __device__ __forceinline__ void gemm_phase(LAS unsigned char* lds, const Gemm g, const Order& S, const Epi<MODE>& E, int tid) {
    const int wid = __builtin_amdgcn_readfirstlane(tid >> 6), lane = tid & 63, wr = wid >> 2, wc = wid & 3, fr = lane & 15, fq = lane >> 4;
    const int K = g.K, nt = K / BK;
    unsigned voffA[2], voffB[2];
#pragma unroll
    for (int i = 0; i < 2; ++i) { int R, C; stage_rc(tid * 16 + i * 8192, R, C); const int Rb = (R & ~31) + perm32(R & 31);
        voffA[i] = (unsigned)(R * g.lda + C) * 2u; voffB[i] = (unsigned)(Rb * g.ldb + C) * 2u; }
    const size_t kstep = (size_t)(BK * 2);
    const size_t hstepA = (size_t)HALF * g.lda * 2, hstepB = (size_t)HALF * g.ldb * 2;
    const size_t tstepA = 2 * hstepA, tstepB = 2 * hstepB;
    const unsigned ldsw = (unsigned)wid * 1024u;
    const int aoff = lds_byte(wr * 64 + fr, fq * 8), boff = lds_byte(wc * 32 + fr, fq * 8);
#define PG8_SA(b, h) (((b) * 2 + (h)) * HTB)
#define PG8_SB(b, h) ((4 + (b) * 2 + (h)) * HTB)
#define PG8_STAGE(bufoff, gbase, voff) do { _Pragma("unroll") for (int _i = 0; _i < 2; ++_i) \
        __builtin_amdgcn_global_load_lds((const unsigned*)((const char*)(gbase) + (voff)[_i]), (LAS unsigned*)(lds + (bufoff) + ldsw + _i * 8192), 16, 0, 0); } while (0)
#define PG8_LDA(dst, b, h) do { _Pragma("unroll") for (int m = 0; m < 4; ++m) _Pragma("unroll") for (int k = 0; k < 2; ++k) dst[m][k] = *(const LAS bf16x8*)(lds + PG8_SA(b, h) + aoff + m * 2048 + k * 1024); } while (0)
#define PG8_LDB(dst, b, h) do { _Pragma("unroll") for (int n = 0; n < 2; ++n) _Pragma("unroll") for (int k = 0; k < 2; ++k) dst[n][k] = *(const LAS bf16x8*)(lds + PG8_SB(b, h) + boff + n * 2048 + k * 1024); } while (0)
#define PG8_MMA(ai, bj, At, Bt) do { __builtin_amdgcn_s_setprio(1); _Pragma("unroll") for (int m = 0; m < 4; ++m) _Pragma("unroll") for (int n = 0; n < 2; ++n) _Pragma("unroll") for (int k = 0; k < 2; ++k) \
        acc[ai][bj][m][n] = __builtin_amdgcn_mfma_f32_16x16x32_bf16(Bt[n][k], At[m][k], acc[ai][bj][m][n], 0, 0, 0); __builtin_amdgcn_s_setprio(0); } while (0)
#define PG8_WAIT_V(n) asm volatile("s_waitcnt vmcnt(" #n ")" ::: "memory")
#define PG8_WAIT_L(n) asm volatile("s_waitcnt lgkmcnt(" #n ")" ::: "memory")
#define PG8_BAR __builtin_amdgcn_s_barrier()
#define PG8_SCHED __builtin_amdgcn_sched_barrier(0)
    Unit cur, nxt; int ui = 0;
    if (!S.next(0, cur)) return;
    f32x4 acc[2][2][4][2];
#pragma unroll
    for (int a = 0; a < 2; ++a)
#pragma unroll
        for (int b = 0; b < 2; ++b)
#pragma unroll
            for (int m = 0; m < 4; ++m)
#pragma unroll
                for (int n = 0; n < 2; ++n) acc[a][b][m][n] = (f32x4){0.f, 0.f, 0.f, 0.f};
    bf16x8 At[4][2], B0[2][2], B1[2][2];
    const char* cA = (const char*)g.A + (size_t)cur.pm * tstepA; const char* cB = (const char*)g.Bt + (size_t)cur.pn * tstepB;
    PG8_STAGE(PG8_SB(0, 0), cB, voffB); PG8_STAGE(PG8_SB(0, 1), cB + hstepB, voffB); PG8_STAGE(PG8_SA(0, 0), cA, voffA); PG8_STAGE(PG8_SA(0, 1), cA + hstepA, voffA);
    if (wr == 1) PG8_BAR;
    PG8_WAIT_V(2); PG8_BAR;
    PG8_STAGE(PG8_SB(1, 0), cB + kstep, voffB); PG8_STAGE(PG8_SA(1, 0), cA + kstep, voffA); PG8_STAGE(PG8_SB(1, 1), cB + hstepB + kstep, voffB);
    PG8_WAIT_V(6); PG8_BAR;
    for (;;) {
        const bool has_next = S.next(ui + 1, nxt);
        const char* nA = has_next ? (const char*)g.A + (size_t)nxt.pm * tstepA : cA; const char* nB = has_next ? (const char*)g.Bt + (size_t)nxt.pn * tstepB : cB;
        for (int t = 0; t < nt; t += 2) {
            const bool last = (t == nt - 2);
            const char* a1 = cA + (size_t)(t + 1) * kstep;
            const char* a2 = last ? nA : cA + (size_t)(t + 2) * kstep; const char* b2 = last ? nB : cB + (size_t)(t + 2) * kstep;
            const char* a3 = a2 + kstep; const char* b3 = b2 + kstep;
            PG8_LDB(B0, 0, 0); PG8_LDB(B1, 0, 1); PG8_SCHED; PG8_LDA(At, 0, 0); PG8_STAGE(PG8_SA(1, 1), a1 + hstepA, voffA);
            PG8_WAIT_V(8); PG8_WAIT_L(0); PG8_BAR; PG8_MMA(0, 0, At, B0); PG8_MMA(0, 1, At, B1); PG8_BAR; PG8_SCHED;
            PG8_LDA(At, 0, 1); PG8_STAGE(PG8_SB(0, 0), b2, voffB); PG8_STAGE(PG8_SB(0, 1), b2 + hstepB, voffB); PG8_STAGE(PG8_SA(0, 0), a2, voffA);
            PG8_WAIT_V(8); PG8_WAIT_L(0); PG8_BAR; PG8_MMA(1, 0, At, B0); PG8_MMA(1, 1, At, B1); PG8_BAR; PG8_SCHED;
            PG8_LDB(B0, 1, 0); PG8_LDB(B1, 1, 1); PG8_SCHED; PG8_LDA(At, 1, 0); PG8_STAGE(PG8_SA(0, 1), a2 + hstepA, voffA);
            PG8_WAIT_V(8); PG8_WAIT_L(0); PG8_BAR; PG8_MMA(0, 0, At, B0); PG8_MMA(0, 1, At, B1); PG8_BAR; PG8_SCHED;
            PG8_LDA(At, 1, 1); PG8_STAGE(PG8_SB(1, 0), b3, voffB); PG8_STAGE(PG8_SB(1, 1), b3 + hstepB, voffB); PG8_STAGE(PG8_SA(1, 0), a3, voffA);
            PG8_WAIT_V(8); PG8_WAIT_L(0); PG8_BAR; PG8_MMA(1, 0, At, B0); PG8_MMA(1, 1, At, B1); PG8_BAR; PG8_SCHED;
        }
        if (wr == 0) PG8_BAR;
        { const int l2 = lane_id(); E(acc, cur, wr, wc, l2 & 15, l2 >> 4); }
        if (!has_next) break;
#pragma unroll
        for (int a = 0; a < 2; ++a)
#pragma unroll
            for (int b = 0; b < 2; ++b)
#pragma unroll
                for (int m = 0; m < 4; ++m)
#pragma unroll
                    for (int n = 0; n < 2; ++n) acc[a][b][m][n] = (f32x4){0.f, 0.f, 0.f, 0.f};
        cur = nxt; cA = nA; cB = nB; ++ui;
        if (wr == 1) PG8_BAR;
    }
    PG8_WAIT_V(0);
    PG8_BAR;
#undef PG8_SA
#undef PG8_SB
#undef PG8_STAGE
#undef PG8_LDA
#undef PG8_LDB
#undef PG8_MMA
#undef PG8_WAIT_V
#undef PG8_WAIT_L
#undef PG8_BAR
#undef PG8_SCHED
}

__device__ __forceinline__ int src_col(int mode, int n) {
    if (mode == 1) { if (n >= 1280) return n; const int pos = n & 127, mm = pos >> 1, sec = pos & 1; const int i = mm + ((mm >= 32) ? 32 : 0); return (n & ~127) + i + 32 * sec; }
    if (mode == 2) { const int t = n >> 8, w = n & 255; return (w < 128) ? t * 128 + w : 512 + t * 128 + (w - 128); }
    return n;
}
__device__ __forceinline__ void p0_transpose_item(const float* W, int K, int N, bf16_t* WT, int mode, LAS float* scr, int item, int lane) {
    const int nblk = N / 32, kb = item / nblk, nb = item % nblk, k0 = 64 * kb, n0 = 32 * nb;
    const int sc = src_col(mode, n0 + (lane & 31));
#pragma unroll 8
    for (int i = 0; i < 32; ++i) { const int kk = 2 * i + (lane >> 5); scr[kk * 33 + (lane & 31)] = W[(size_t)(k0 + kk) * N + sc]; }
    LDS_WAIT(); asm volatile("" ::: "memory");
    const int c = lane & 7;
#pragma unroll
    for (int j = 0; j < 4; ++j) { const int n = (lane >> 3) + 8 * j; const LAS float* s = scr + (8 * c) * 33 + n;
        u32x4 o; o.x = pk2(s[0 * 33], s[1 * 33]); o.y = pk2(s[2 * 33], s[3 * 33]); o.z = pk2(s[4 * 33], s[5 * 33]); o.w = pk2(s[6 * 33], s[7 * 33]);
        *(u32x4*)(WT + (size_t)(n0 + n) * K + k0 + 8 * c) = o; }
    LDS_WAIT(); asm volatile("" ::: "memory");
}

__device__ __forceinline__ void ada_item(LAS unsigned char* lds, int item, int tid) {
    LAS float* scv = (LAS float*)lds;
    LAS float* red = (LAS float*)(lds + 73728);
    for (int i = tid; i < 9 * DM; i += 512) { const float v = (i < 8 * DM) ? KP->in[1][i] : KP->in[3][i - 8 * DM]; scv[i] = v / (1.f + __expf(-v)); }
    __syncthreads();
    const int cl = tid & 15, kg = tid >> 4, n0 = item * 64;
    const float* w = KP->in[4] + (size_t)(kg * 64) * 12288 + n0 + 4 * cl;
    f32x4 a[9];
#pragma unroll
    for (int m = 0; m < 9; ++m) a[m] = (f32x4){0.f, 0.f, 0.f, 0.f};
#pragma unroll 4
    for (int k = 0; k < 64; ++k) { const f32x4 wv = *(const f32x4*)(w + (size_t)k * 12288);
#pragma unroll
        for (int m = 0; m < 9; ++m) a[m] += wv * scv[m * DM + kg * 64 + k]; }
#pragma unroll
    for (int m = 0; m < 9; ++m) *(LAS f32x4*)(red + (kg * 9 + m) * 64 + 4 * cl) = a[m];
    __syncthreads();
    float* MOD = (float*)(KP->ws + WS_MOD);
    for (int i = tid; i < 9 * 64; i += 512) { const int m = i >> 6, col = i & 63; float s = KP->in[5][n0 + col];
        for (int q = 0; q < 32; ++q) s += red[(q * 9 + m) * 64 + col];
        MOD[(size_t)m * 12288 + n0 + col] = s; }
    __syncthreads();
}

__device__ __forceinline__ void s5_precompute(LAS unsigned char* lds, int g, int tid) {
    LAS float* Ere = (LAS float*)lds;
    LAS float* Eim = Ere + 2176;
    LAS float* Bre = Eim + 2176;
    LAS float* Bim = Bre + 2048;
    LAS float* Cre = Bim + 2048;
    LAS float* Cim = Cre + 2048;
    LAS float* Cf = Cim + 2048;
    float* LAMT = (float*)(KP->ws + WS_LAMT);
    if (tid < 128) {
        const int dir = tid >> 6, pp = tid & 63;
        const float are = KP->in[8][(dir * 32 + g) * 64 + pp], aim = KP->in[9][(dir * 32 + g) * 64 + pp];
        const float dt = expf(KP->in[10][dir * 32 + g]);
        const float mag = expf(are * dt); float sn, cs; sincosf(aim * dt, &sn, &cs);
        const float lr = mag * cs, li = mag * sn;
        const float nr = lr - 1.f, ni = li, den = are * are + aim * aim;
        Cf[tid * 2] = (nr * are + ni * aim) / den; Cf[tid * 2 + 1] = (ni * are - nr * aim) / den;
        float er = 1.f, ei = 0.f;
        for (int d = 0; d <= 16; ++d) { Ere[tid * 17 + d] = er; Eim[tid * 17 + d] = ei;
            if (d == 16) { LAMT[((g * 2 + dir) * 2 + 0) * 64 + pp] = er; LAMT[((g * 2 + dir) * 2 + 1) * 64 + pp] = ei; }
            const float t = er * lr - ei * li; ei = er * li + ei * lr; er = t; }
    }
    __syncthreads();
    for (int idx = tid; idx < 2048; idx += 512) { const int dir = idx >> 10, pp = (idx >> 4) & 63, h = idx & 15;
        const size_t si = ((size_t)(dir * 32 + g) * 64 + pp) * 16 + h; const float br = KP->in[11][si], bi = KP->in[12][si];
        const float cr = Cf[(dir * 64 + pp) * 2], ci = Cf[(dir * 64 + pp) * 2 + 1];
        Bre[idx] = cr * br - ci * bi; Bim[idx] = cr * bi + ci * br;
        const int hh = (idx >> 6) & 15, p2 = idx & 63; const size_t ci2 = ((size_t)(dir * 32 + g) * 16 + hh) * 64 + p2;
        Cre[idx] = KP->in[13][ci2]; Cim[idx] = KP->in[14][ci2]; }
    __syncthreads();
    bf16_t* Wm = (bf16_t*)(KP->ws + WS_WMAT) + (size_t)g * 256 * 256;
    bf16_t* Mm = (bf16_t*)(KP->ws + WS_MMAT) + (size_t)g * 256 * 512;
    for (int idx = tid; idx < 65536; idx += 512) {
        {
            const int n = idx >> 8, k = idx & 255, dir = n >> 7, ri = (n >> 6) & 1, pp = n & 63, j = k >> 4, hh = k & 15, e = dir ? j : 15 - j;
            const float er = Ere[(dir * 64 + pp) * 17 + e], ei = Eim[(dir * 64 + pp) * 17 + e], br = Bre[(dir * 64 + pp) * 16 + hh], bi = Bim[(dir * 64 + pp) * 16 + hh];
            Wm[idx] = (bf16_t)f2bf(ri ? (er * bi + ei * br) : (er * br - ei * bi));
        }
        {
            const int row = idx >> 8, t = row >> 4, hh = row & 15, cc = idx & 255, dir = cc >> 7, ri = (cc >> 6) & 1, pp = cc & 63, e = dir ? 16 - t : t + 1;
            const float er = Ere[(dir * 64 + pp) * 17 + e], ei = Eim[(dir * 64 + pp) * 17 + e], cr = Cre[(dir * 16 + hh) * 64 + pp], ci = Cim[(dir * 16 + hh) * 64 + pp];
            Mm[(size_t)row * 512 + 256 + cc] = (bf16_t)f2bf(ri ? -(cr * ei + ci * er) : (cr * er - ci * ei));
        }
    }
    if (tid < 496) {
        const int dd = tid / 16 - 15, hh = tid & 15, e = dd < 0 ? -dd : dd;
        float kv[16];
#pragma unroll
        for (int q = 0; q < 16; ++q) kv[q] = 0.f;
#pragma unroll
        for (int dir = 0; dir < 2; ++dir) {
            const bool on = dir == 0 ? (dd >= 0) : (dd <= 0);
            if (on) {
                for (int pp = 0; pp < 64; ++pp) {
                    const float er = Ere[(dir * 64 + pp) * 17 + e], ei = Eim[(dir * 64 + pp) * 17 + e], cr = Cre[(dir * 16 + hh) * 64 + pp], ci = Cim[(dir * 16 + hh) * 64 + pp];
                    const float gr = cr * er - ci * ei, gi = cr * ei + ci * er;
#pragma unroll
                    for (int q = 0; q < 16; ++q) kv[q] += gr * Bre[(dir * 64 + pp) * 16 + q] - gi * Bim[(dir * 64 + pp) * 16 + q];
                }
            }
        }
        if (dd == 0) { const float dv = KP->in[15][g * 16 + hh];
#pragma unroll
            for (int q = 0; q < 16; ++q) kv[q] += (q == hh) ? dv : 0.f; }
        u32x4 w0, w1;
        w0.x = pk2(kv[0], kv[1]); w0.y = pk2(kv[2], kv[3]); w0.z = pk2(kv[4], kv[5]); w0.w = pk2(kv[6], kv[7]);
        w1.x = pk2(kv[8], kv[9]); w1.y = pk2(kv[10], kv[11]); w1.z = pk2(kv[12], kv[13]); w1.w = pk2(kv[14], kv[15]);
        for (int t = 0; t < 16; ++t) { const int j = t - dd; if (j >= 0 && j < 16) { bf16_t* dst = Mm + (size_t)(t * 16 + hh) * 512 + j * 16; *(u32x4*)dst = w0; *(u32x4*)(dst + 8) = w1; } }
    }
    __syncthreads();
}

__device__ __forceinline__ void step_prologue(LAS unsigned char* lds, int tid) {
    const int lane = tid & 63, wave = tid >> 6;
    for (int it = blockIdx.x; it < 225; it += gridDim.x) {
        if (it < 32) s5_precompute(lds, it, tid);
        else if (it < 224) ada_item(lds, it - 32, tid);
        else { float* rope = (float*)(KP->ws + WS_ROPE);
            for (int idx = tid; idx < 2048; idx += 512) { const int pos = idx >> 5, f = idx & 31; const float fr_ = powf(10000.f, -(float)f / 32.f); const float ang = (float)pos * fr_;
                rope[idx * 2] = cosf(ang); rope[idx * 2 + 1] = sinf(ang); } }
    }
    __syncthreads();
    LAS float* scr = (LAS float*)(lds + wave * 16384);
    const int gw = blockIdx.x * 8 + wave, NGW = gridDim.x * 8;
    constexpr int I_IN = 32 * 192, I_GLU = 8 * 32, I_AUP = 16 * 64, I_SUP = 8 * 64, I_OUT = 32 * 64, I_M1 = 32 * 256, I_M2 = 128 * 64;
    constexpr int NITEMS = I_IN + I_GLU + I_AUP + I_SUP + I_OUT + I_M1 + I_M2;
    unsigned char* ws = KP->ws;
    for (int it = gw; it < NITEMS; it += NGW) {
        int r = it;
        if (r < I_IN) { p0_transpose_item(KP->in[6], DM, INC, (bf16_t*)(ws + WS_WTIN), 1, scr, r, lane); continue; } r -= I_IN;
        if (r < I_GLU) { p0_transpose_item(KP->in[16], SW, 2 * SW, (bf16_t*)(ws + WS_WTGLU), 2, scr, r, lane); continue; } r -= I_GLU;
        if (r < I_AUP) { p0_transpose_item(KP->in[17], QW, DM, (bf16_t*)(ws + WS_WTAUP), 0, scr, r, lane); continue; } r -= I_AUP;
        if (r < I_SUP) { p0_transpose_item(KP->in[18], SW, DM, (bf16_t*)(ws + WS_WTSUP), 0, scr, r, lane); continue; } r -= I_SUP;
        if (r < I_OUT) { p0_transpose_item(KP->in[19], DM, DM, (bf16_t*)(ws + WS_WTOUT), 0, scr, r, lane); continue; } r -= I_OUT;
        if (r < I_M1) { p0_transpose_item(KP->in[22], DM, DFF, (bf16_t*)(ws + WS_WTM1), 0, scr, r, lane); continue; } r -= I_M1;
        p0_transpose_item(KP->in[24], DFF, DM, (bf16_t*)(ws + WS_WTM2), 0, scr, r, lane);
    }
}

__device__ __forceinline__ void ln_stats(const f32x4 (&v)[8], float& mean, float& rstd) {
    float s = 0.f;
#pragma unroll
    for (int j = 0; j < 8; ++j) s += (v[j][0] + v[j][1]) + (v[j][2] + v[j][3]);
    mean = wave_sum(s) * (1.f / DM); float q = 0.f;
#pragma unroll
    for (int j = 0; j < 8; ++j) { const f32x4 d = v[j] - mean; q += (d[0] * d[0] + d[1] * d[1]) + (d[2] * d[2] + d[3] * d[3]); }
    rstd = rsqrtf(wave_sum(q) * (1.f / DM) + LN_EPS);
}
__device__ __forceinline__ void step_ln1(int tid) {
    const int lane = tid & 63, gw = blockIdx.x * 8 + (tid >> 6), NGW = gridDim.x * 8;
    const float* MOD = (const float*)(KP->ws + WS_MOD); bf16_t* H = (bf16_t*)(KP->ws + WS_HALL);
    for (int r = gw; r < MALL; r += NGW) {
        const float* src = (r < MLAT) ? KP->in[0] + (size_t)r * DM : KP->in[2] + (size_t)(r - MLAT) * DM;
        const float* md = MOD + (size_t)((r < MLAT) ? (r >> 11) : 8) * 12288;
        f32x4 v[8];
#pragma unroll
        for (int j = 0; j < 8; ++j) v[j] = *(const f32x4*)(src + 4 * (lane + 64 * j));
        float mean, rstd; ln_stats(v, mean, rstd);
#pragma unroll
        for (int j = 0; j < 8; ++j) { const int c = 4 * (lane + 64 * j); const f32x4 sh = *(const f32x4*)(md + c), sc = *(const f32x4*)(md + DM + c);
            const f32x4 o = (v[j] - mean) * rstd * (sc + 1.f) + sh;
            u32x2 w; w.x = cvt_pk_bf16(o[0], o[1]); w.y = cvt_pk_bf16(o[2], o[3]); *(u32x2*)(H + (size_t)r * DM + c) = w; }
    }
}
__device__ __forceinline__ void step_ln2(int tid) {
    const int lane = tid & 63, gw = blockIdx.x * 8 + (tid >> 6), NGW = gridDim.x * 8;
    const float* MOD = (const float*)(KP->ws + WS_MOD); bf16_t* H = (bf16_t*)(KP->ws + WS_H2);
    const float* lg = KP->in[20]; const float* lb = KP->in[21];
    for (int r = gw; r < MLAT; r += NGW) {
        float* row = KP->out + (size_t)r * DM; const float* md = MOD + (size_t)(r >> 11) * 12288;
        f32x4 v[8];
#pragma unroll
        for (int j = 0; j < 8; ++j) v[j] = *(const f32x4*)(row + 4 * (lane + 64 * j));
        float mean, rstd; ln_stats(v, mean, rstd);
#pragma unroll
        for (int j = 0; j < 8; ++j) { const int c = 4 * (lane + 64 * j); v[j] = (v[j] - mean) * rstd * *(const f32x4*)(lg + c) + *(const f32x4*)(lb + c); *(f32x4*)(row + c) = v[j]; }
        ln_stats(v, mean, rstd);
#pragma unroll
        for (int j = 0; j < 8; ++j) { const int c = 4 * (lane + 64 * j); const f32x4 sh = *(const f32x4*)(md + 3 * DM + c), sc = *(const f32x4*)(md + 4 * DM + c);
            const f32x4 o = (v[j] - mean) * rstd * (sc + 1.f) + sh;
            u32x2 w; w.x = cvt_pk_bf16(o[0], o[1]); w.y = cvt_pk_bf16(o[2], o[3]); *(u32x2*)(H + (size_t)r * DM + c) = w; }
    }
}
__device__ __forceinline__ void step_ln3(int tid) {
    const int lane = tid & 63, gw = blockIdx.x * 8 + (tid >> 6), NGW = gridDim.x * 8;
    const float* lg = KP->in[26]; const float* lb = KP->in[27];
    for (int r = gw; r < MLAT; r += NGW) {
        float* row = KP->out + (size_t)r * DM;
        f32x4 v[8];
#pragma unroll
        for (int j = 0; j < 8; ++j) v[j] = *(const f32x4*)(row + 4 * (lane + 64 * j));
        float mean, rstd; ln_stats(v, mean, rstd);
#pragma unroll
        for (int j = 0; j < 8; ++j) { const int c = 4 * (lane + 64 * j); *(f32x4*)(row + c) = (v[j] - mean) * rstd * *(const f32x4*)(lg + c) + *(const f32x4*)(lb + c); }
    }
}

constexpr int KS_PITCH = 272, VT_PITCH = 144, VT_OFF = 64 * KS_PITCH;
__device__ __forceinline__ void step_attn(LAS unsigned char* lds, int tid) {
    const int w = tid >> 6, lane = tid & 63, fr = lane & 15, fq = lane >> 4;
    const bf16_t* Qb = (const bf16_t*)(KP->ws + WS_QB); const bf16_t* Kb = (const bf16_t*)(KP->ws + WS_KB); const bf16_t* Vtg = (const bf16_t*)(KP->ws + WS_VT);
    bf16_t* AO = (bf16_t*)(KP->ws + WS_ATTN);
    for (int item = blockIdx.x; item < 512; item += gridDim.x) {
        const int hp = item & 1, n = (item >> 1) & 15, kvh = (item >> 5) & 1, b = item >> 6;
        const int head = kvh * 4 + hp * 2 + (w >> 2);
        const int q0 = n * 128 + (w & 3) * 32;
        bf16x8 qf[2][4];
#pragma unroll
        for (int qb = 0; qb < 2; ++qb)
#pragma unroll
            for (int ks = 0; ks < 4; ++ks) qf[qb][ks] = *(const bf16x8*)(Qb + (size_t)(b * SEQ + q0 + 16 * qb + fr) * QW + head * HD + 32 * ks + 8 * fq);
        const float sk = KP->in[7][head] * LOG2E;
        float m_[2] = {sk, sk}, l_[2]; l_[0] = l_[1] = (fq == 0) ? 1.f : 0.f;
        f32x4 o[2][8];
#pragma unroll
        for (int qb = 0; qb < 2; ++qb)
#pragma unroll
            for (int db = 0; db < 8; ++db) o[qb][db] = (f32x4){0.f, 0.f, 0.f, 0.f};
        const int tb_lo = (n == 0) ? 2 : 0, tb_hi = (n == 15) ? 4 : 6, nbt = tb_hi - tb_lo, ntile = nbt + 4;
        const bf16_t* kbase = Kb + (size_t)b * KROWS * 256 + kvh * HD;
        const bf16_t* vbase = Vtg + (size_t)(b * 2 + kvh) * HD * KROWS;
        u32x4 kr[2], vr[2];
        {   const int krow0 = 128 * (n - 1) + 64 * tb_lo;
#pragma unroll
            for (int i = 0; i < 2; ++i) { const int c = tid + 512 * i; kr[i] = *(const u32x4*)(kbase + (size_t)(krow0 + (c >> 4)) * 256 + (c & 15) * 8);
                vr[i] = *(const u32x4*)(vbase + (size_t)(c >> 3) * KROWS + krow0 + (c & 7) * 8); } }
        for (int t = 0; t < ntile; ++t) {
            __syncthreads();
#pragma unroll
            for (int i = 0; i < 2; ++i) { const int c = tid + 512 * i; *(LAS u32x4*)(lds + (c >> 4) * KS_PITCH + (c & 15) * 16) = kr[i];
                *(LAS u32x4*)(lds + VT_OFF + (c >> 3) * VT_PITCH + (c & 7) * 16) = vr[i]; }
            __syncthreads();
            const bool band = t < nbt;
            const int kp0 = band ? 128 * (n - 1) + 64 * (tb_lo + t) : 0;
            if (t + 1 < ntile) { const int t1 = t + 1; const int krow0 = (t1 < nbt) ? 128 * (n - 1) + 64 * (tb_lo + t1) : SEQ + 64 * (t1 - nbt);
#pragma unroll
                for (int i = 0; i < 2; ++i) { const int c = tid + 512 * i; kr[i] = *(const u32x4*)(kbase + (size_t)(krow0 + (c >> 4)) * 256 + (c & 15) * 8);
                    vr[i] = *(const u32x4*)(vbase + (size_t)(c >> 3) * KROWS + krow0 + (c & 7) * 8); } }
            if (band && (kp0 + 63 < q0 - 128 || kp0 > q0 + 31 + 128)) continue;
            f32x4 s[4][2];
#pragma unroll
            for (int kb = 0; kb < 4; ++kb)
#pragma unroll
                for (int qb = 0; qb < 2; ++qb) s[kb][qb] = (f32x4){0.f, 0.f, 0.f, 0.f};
#pragma unroll
            for (int kb = 0; kb < 4; ++kb)
#pragma unroll
                for (int ks = 0; ks < 4; ++ks) { const bf16x8 kf = *(const LAS bf16x8*)(lds + (16 * kb + fr) * KS_PITCH + (32 * ks + 8 * fq) * 2);
#pragma unroll
                    for (int qb = 0; qb < 2; ++qb) s[kb][qb] = __builtin_amdgcn_mfma_f32_16x16x32_bf16(kf, qf[qb][ks], s[kb][qb], 0, 0, 0); }
            if (band) {
#pragma unroll
                for (int kb = 0; kb < 4; ++kb)
#pragma unroll
                    for (int qb = 0; qb < 2; ++qb)
#pragma unroll
                        for (int r = 0; r < 4; ++r) { const int dq = (q0 + 16 * qb + fr) - (kp0 + 16 * kb + 4 * fq + r); if (dq > 128 || dq < -128) s[kb][qb][r] = -1e30f; }
            }
            bf16x8 pa[2][2];
#pragma unroll
            for (int qb = 0; qb < 2; ++qb) {
                float mx = s[0][qb][0];
#pragma unroll
                for (int kb = 0; kb < 4; ++kb)
#pragma unroll
                    for (int r = 0; r < 4; ++r) mx = fmaxf(mx, s[kb][qb][r]);
                mx = fmaxf(mx, __shfl_xor(mx, 16)); mx = fmaxf(mx, __shfl_xor(mx, 32));
                const float mn = fmaxf(m_[qb], mx), alpha = exp2f(m_[qb] - mn); m_[qb] = mn;
                float rs = 0.f;
#pragma unroll
                for (int kb = 0; kb < 4; ++kb)
#pragma unroll
                    for (int r = 0; r < 4; ++r) { const float pv = exp2f(s[kb][qb][r] - mn); rs += pv; s[kb][qb][r] = pv; }
                l_[qb] = l_[qb] * alpha + rs;
#pragma unroll
                for (int r = 0; r < 4; ++r) { const float ar = __shfl(alpha, 4 * fq + r);
#pragma unroll
                    for (int db = 0; db < 8; ++db) o[qb][db][r] *= ar; }
#pragma unroll
                for (int kk = 0; kk < 2; ++kk) { u32x4 w4; w4.x = cvt_pk_bf16(s[2 * kk][qb][0], s[2 * kk][qb][1]); w4.y = cvt_pk_bf16(s[2 * kk][qb][2], s[2 * kk][qb][3]);
                    w4.z = cvt_pk_bf16(s[2 * kk + 1][qb][0], s[2 * kk + 1][qb][1]); w4.w = cvt_pk_bf16(s[2 * kk + 1][qb][2], s[2 * kk + 1][qb][3]);
                    pa[qb][kk] = __builtin_bit_cast(bf16x8, w4); }
            }
#pragma unroll
            for (int kk = 0; kk < 2; ++kk)
#pragma unroll
                for (int db = 0; db < 8; ++db) { const LAS unsigned char* vp = lds + VT_OFF + (16 * db + fr) * VT_PITCH + (32 * kk + 4 * fq) * 2;
                    const u32x2 lo = *(const LAS u32x2*)vp, hi = *(const LAS u32x2*)(vp + 32);
                    u32x4 v4; v4.x = lo.x; v4.y = lo.y; v4.z = hi.x; v4.w = hi.y; const bf16x8 vf = __builtin_bit_cast(bf16x8, v4);
#pragma unroll
                    for (int qb = 0; qb < 2; ++qb) o[qb][db] = __builtin_amdgcn_mfma_f32_16x16x32_bf16(pa[qb][kk], vf, o[qb][db], 0, 0, 0); }
        }
#pragma unroll
        for (int qb = 0; qb < 2; ++qb) { float lt = l_[qb]; lt += __shfl_xor(lt, 16); lt += __shfl_xor(lt, 32); const float inv = 1.f / lt;
#pragma unroll
            for (int r = 0; r < 4; ++r) { const float ir = __shfl(inv, 4 * fq + r); bf16_t* dst = AO + (size_t)(b * SEQ + q0 + 16 * qb + 4 * fq + r) * QW + head * HD + fr;
#pragma unroll
                for (int db = 0; db < 8; ++db) dst[16 * db] = (bf16_t)f2bf(o[qb][db][r] * ir); } }
    }
    __syncthreads();
}

__device__ __forceinline__ void step_scan(int tid) {
    if (tid >= 128) return;
    const int idx = blockIdx.x * 128 + tid; if (idx >= 32768) return;
    const int pp = idx & 63, dir = (idx >> 6) & 1, b = (idx >> 7) & 7, g = idx >> 10;
    const float* LAMT = (const float*)(KP->ws + WS_LAMT);
    const float lr = LAMT[((g * 2 + dir) * 2 + 0) * 64 + pp], li = LAMT[((g * 2 + dir) * 2 + 1) * 64 + pp];
    const float* SL = (const float*)(KP->ws + WS_SLOC) + (size_t)g * S5ROWS * 256 + dir * 128 + pp;
    bf16_t* U = (bf16_t*)(KP->ws + WS_U) + (size_t)g * S5ROWS * 512 + 256 + dir * 128 + pp;
    float sr = 0.f, si = 0.f;
    for (int c0 = 0; c0 < 144; c0 += 16) {
        float xr[16], xi[16];
#pragma unroll
        for (int q = 0; q < 16; ++q) { const int s = c0 + q; int row;
            if (s < 16) row = 1024 + b * 16 + (dir ? 15 - s : s); else row = b * 128 + (dir ? 127 - (s - 16) : (s - 16));
            xr[q] = SL[(size_t)row * 256]; xi[q] = SL[(size_t)row * 256 + 64]; }
#pragma unroll
        for (int q = 0; q < 16; ++q) { const int s = c0 + q;
            if (s >= 16) { const int row = b * 128 + (dir ? 127 - (s - 16) : (s - 16)); U[(size_t)row * 512] = (bf16_t)f2bf(sr); U[(size_t)row * 512 + 64] = (bf16_t)f2bf(si); }
            const float t = lr * sr - li * si + xr[q]; si = lr * si + li * sr + xi[q]; sr = t; }
    }
}

constexpr size_t WS_BAR = 0;
__device__ __forceinline__ void grid_bar(unsigned* ctr, unsigned target, bool leader) {
    asm volatile("s_waitcnt vmcnt(0)" ::: "memory");
    __syncthreads();
    if (leader) {
        __builtin_amdgcn_fence(__ATOMIC_RELEASE, "agent");
        asm volatile("s_waitcnt vmcnt(0)" ::: "memory");
        __hip_atomic_fetch_add(ctr, 1u, __ATOMIC_RELAXED, __HIP_MEMORY_SCOPE_AGENT);
        while (__hip_atomic_load(ctr, __ATOMIC_RELAXED, __HIP_MEMORY_SCOPE_AGENT) < target) __builtin_amdgcn_s_sleep(1);
        __builtin_amdgcn_fence(__ATOMIC_ACQUIRE, "agent");
        asm volatile("s_waitcnt vmcnt(0)" ::: "memory");
    }
    __syncthreads();
}

__global__ void __launch_bounds__(512, 2) fwd_kernel(Params p) {
    __builtin_assume(__builtin_amdgcn_workitem_id_y() == 0); __builtin_assume(__builtin_amdgcn_workitem_id_z() == 0);
    extern __shared__ __attribute__((aligned(16))) unsigned char lds_raw[];
    LAS unsigned char* lds = (LAS unsigned char*)lds_raw;
    unsigned char* ws = KP->ws;
    const int G = gridDim.x, c = blockIdx.x, lo = KP->lo, hi = KP->hi;
    const int wave_ = __builtin_amdgcn_readfirstlane(threadIdx.x >> 6);
#define TID (wave_ * 64 + lane_id())
#define IN(k) (lo <= (k) && (k) < hi)
    unsigned nbar = 0;
#define SEAM(k) do { if (IN(k) && IN((k) + 1)) { if ((k) == 0) cg::this_grid().sync(); else { ++nbar; grid_bar((unsigned*)(ws + WS_BAR), nbar * (unsigned)G, wave_ == 0 && lane_id() == 0); } } } while (0)
#define LSEAM(k) do { if (IN(k) && IN((k) + 1)) __syncthreads(); } while (0)
#define GEMM_STEP(k, MODE, Aoff, Boff, LDA, LDB, KK, OM, NM_, NN_, NWG, PA, PB, OUTP) \
    if (IN(k)) for (int rep_ = 0; rep_ <= ((PROBE_MASK >> (k)) & 1); ++rep_) { const Gemm g{(const bf16_t*)(ws + (Aoff)), (const bf16_t*)(ws + (Boff)), LDA, LDB, KK}; const Order S{OM, NM_, NN_, NWG, G, c}; \
        const Epi<MODE> E{ws, PA, PB, OUTP}; gemm_phase<MODE>(lds, g, S, E, TID); }
    if (IN(0)) for (int rep_ = 0; rep_ <= ((PROBE_MASK >> 0) & 1); ++rep_) { step_prologue(lds, TID); __syncthreads(); }
    SEAM(0);
    if (IN(1)) for (int rep_ = 0; rep_ <= ((PROBE_MASK >> 1) & 1); ++rep_) { step_ln1(TID); __syncthreads(); }
    SEAM(1);
    GEMM_STEP(2, E_WIN, WS_HALL, WS_WTIN, DM, DM, DM, 1, 64, 24, 1568, nullptr, nullptr, nullptr)
    SEAM(2);
    if (IN(3)) for (int rep_ = 0; rep_ <= ((PROBE_MASK >> 3) & 1); ++rep_) { step_attn(lds, TID); __syncthreads(); }
    LSEAM(3);
    GEMM_STEP(4, E_S5A, WS_U, WS_WMAT, 512, 256, 256, 2, 5, 1, 160, nullptr, nullptr, nullptr)
    SEAM(4);
    if (IN(5)) for (int rep_ = 0; rep_ <= ((PROBE_MASK >> 5) & 1); ++rep_) { step_scan(TID); __syncthreads(); }
    SEAM(5);
    GEMM_STEP(6, E_S5C, WS_U, WS_MMAT, 512, 512, 512, 2, 4, 1, 128, nullptr, nullptr, nullptr)
    SEAM(6);
    GEMM_STEP(7, E_GLU, WS_SACT, WS_WTGLU, SW, SW, SW, 0, 64, 4, 256, nullptr, nullptr, nullptr)
    SEAM(7);
    GEMM_STEP(8, E_AUP, WS_ATTN, WS_WTAUP, QW, QW, QW, 0, 64, 8, 512, nullptr, nullptr, nullptr)
    LSEAM(8);
    GEMM_STEP(9, E_SUP, WS_SGLU, WS_WTSUP, SW, SW, SW, 0, 64, 8, 512, nullptr, nullptr, nullptr)
    SEAM(9);
    GEMM_STEP(10, E_WOUT, WS_MERG, WS_WTOUT, DM, DM, DM, 0, 64, 8, 512, KP->in[0], nullptr, KP->out)
    SEAM(10);
    if (IN(11)) step_ln2(TID);
    SEAM(11);
    GEMM_STEP(12, E_M1, WS_H2, WS_WTM1, DM, DM, DM, 0, 64, 32, 2048, KP->in[23], nullptr, nullptr)
    SEAM(12);
    GEMM_STEP(13, E_M2, WS_HID, WS_WTM2, DFF, DFF, DFF, 0, 64, 8, 512, KP->in[25], nullptr, KP->out)
    SEAM(13);
    if (IN(14)) step_ln3(TID);
#undef IN
#undef TID
#undef SEAM
#undef LSEAM
#undef GEMM_STEP
}

extern "C" void kernel_launch(void* const* d_in, const int* in_sizes, int n_in, void* d_out, int out_size, void* d_ws, size_t ws_size, hipStream_t stream) {
    static int grid = 0;
    if (grid == 0) {
        if (n_in != 28 || out_size != MLAT * DM || ws_size < WS_NEED) { fprintf(stderr, "kernel_launch: unexpected shapes (n_in %d out %d ws %zu)\n", n_in, out_size, ws_size); grid = -1; return; }
        int dev = 0, cus = 0, per_cu = 0;
        hipGetDevice(&dev); hipDeviceGetAttribute(&cus, hipDeviceAttributeMultiprocessorCount, dev);
        if (hipFuncSetAttribute((const void*)fwd_kernel, hipFuncAttributeMaxDynamicSharedMemorySize, LDS_BYTES) != hipSuccess) { fprintf(stderr, "kernel_launch: hipFuncSetAttribute failed\n"); grid = -1; return; }
        if (hipOccupancyMaxActiveBlocksPerMultiprocessor(&per_cu, (const void*)fwd_kernel, 512, LDS_BYTES) != hipSuccess || per_cu < 1) { fprintf(stderr, "kernel_launch: occupancy query gives %d\n", per_cu); (void)hipGetLastError(); per_cu = 1; }
        grid = cus;
        if (grid <= 0) grid = 256;
    }
    if (grid < 0) return;
    Params p{};
    for (int i = 0; i < 28; ++i) p.in[i] = (const float*)d_in[i];
    p.out = (float*)d_out; p.ws = (unsigned char*)d_ws;
#if N_LAUNCH_MODE == 1
    if (hipMemsetAsync((char*)d_ws + WS_BAR, 0, 256, stream) != hipSuccess) { fprintf(stderr, "kernel_launch: memset failed\n"); return; }
    p.lo = 0; p.hi = NSTEPS;
    void* args[] = {&p};
    hipError_t e = hipLaunchCooperativeKernel((const void*)fwd_kernel, dim3(grid), dim3(512), args, LDS_BYTES, stream);
    if (e != hipSuccess) fprintf(stderr, "cooperative launch failed: %s (grid %d)\n", hipGetErrorString(e), grid);
#else
    for (int st = 0; st < NSTEPS; ++st) {
        p.lo = st; p.hi = st + 1;
        hipLaunchKernelGGL(fwd_kernel, dim3(grid), dim3(512), LDS_BYTES, stream, p);
    }
#endif
}
```

```cpp
#include <hip/hip_runtime.h>
#include <hip/hip_cooperative_groups.h>
#include <cstdio>
#include <cstdint>
namespace cg = cooperative_groups;

#ifndef N_LAUNCH_MODE
#define N_LAUNCH_MODE 1
#endif

#ifndef PROBE_MASK
#define PROBE_MASK 0
#endif
#define LAS __attribute__((address_space(3)))
typedef unsigned short bf16_t;
typedef short bf16x8 __attribute__((ext_vector_type(8)));
typedef float f32x4 __attribute__((ext_vector_type(4)));
typedef float f32x2 __attribute__((ext_vector_type(2)));
typedef unsigned u32x4 __attribute__((ext_vector_type(4)));
typedef unsigned u32x2 __attribute__((ext_vector_type(2)));

constexpr int DM = 2048, NB = 8, SEQ = 2048, CTXL = 256, HD = 128, NH = 8;
constexpr int QW = 1024, SW = 512, INC = 6144, DFF = 8192;
constexpr int MLAT = NB * SEQ, MCTX = NB * CTXL, MALL = MLAT + MCTX;
constexpr int KROWS = SEQ + CTXL;
constexpr int S5ROWS = 1280;
constexpr float ALPHA_F = 1.189207115002721f;
constexpr float LN_EPS = 1e-6f;
constexpr float LOG2E = 1.4426950408889634f;
constexpr float QSCALE = 0.08838834764831845f * LOG2E;
constexpr int NSTEPS = 15;

constexpr size_t MiB = 1u << 20;
constexpr size_t WS_WTIN = 1 * MiB, WS_WTGLU = 25 * MiB, WS_WTAUP = 26 * MiB, WS_WTSUP = 30 * MiB, WS_WTOUT = 32 * MiB, WS_WTM1 = 40 * MiB, WS_WTM2 = 72 * MiB;
constexpr size_t WS_WMAT = 104 * MiB, WS_MMAT = 108 * MiB, WS_MOD = 116 * MiB, WS_ROPE = 117 * MiB, WS_LAMT = 117 * MiB + 512 * 1024;
constexpr size_t WS_HALL = 128 * MiB;
constexpr size_t WS_ATTN = 128 * MiB;
constexpr size_t WS_SLOC = 160 * MiB;
constexpr size_t WS_QB = 200 * MiB, WS_KB = 232 * MiB, WS_VT = 241 * MiB;
constexpr size_t WS_SACT = 250 * MiB;
constexpr size_t WS_MERG = 200 * MiB;
constexpr size_t WS_U = 266 * MiB;
constexpr size_t WS_SGA = 306 * MiB, WS_SGS = 370 * MiB;
constexpr size_t WS_SGLU = 434 * MiB;
constexpr size_t WS_HID = 128 * MiB;
constexpr size_t WS_H2 = 384 * MiB;
constexpr size_t WS_XBUF = 118 * MiB;
constexpr size_t WS_CNT = 4096;
constexpr size_t WS_CTL_BYTES = 65536;
constexpr int XL_OFF = 131072;
constexpr size_t WS_NEED = 450 * MiB;

constexpr int LDS_BYTES = 147456;

struct Params { const float* in[28]; float* out; unsigned char* ws; int lo, hi; };
#define KP ((const __attribute__((address_space(4))) Params*)__builtin_amdgcn_kernarg_segment_ptr())
__device__ __forceinline__ int lane_id() { int l; asm volatile("v_mbcnt_lo_u32_b32 %0, -1, 0\n\tv_mbcnt_hi_u32_b32 %0, -1, %0" : "=v"(l)); return l; }

__device__ __forceinline__ unsigned f2bf(float f) { unsigned u = __builtin_bit_cast(unsigned, f); return (u + 0x7fffu + ((u >> 16) & 1u)) >> 16; }
__device__ __forceinline__ unsigned pk2(float lo, float hi) { return f2bf(lo) | (f2bf(hi) << 16); }
__device__ __forceinline__ unsigned cvt_pk_bf16(float lo, float hi) { unsigned r; asm volatile("v_cvt_pk_bf16_f32 %0, %1, %2" : "=v"(r) : "v"(lo), "v"(hi)); return r; }
__device__ __forceinline__ float bflo(unsigned w) { return __builtin_bit_cast(float, w << 16); }
__device__ __forceinline__ float bfhi(unsigned w) { return __builtin_bit_cast(float, w & 0xffff0000u); }
__device__ __forceinline__ float sigmoidf_(float x) { return 1.f / (1.f + __expf(-x)); }
__device__ __forceinline__ float gelu_tanh(float x) { const float u = 1.5957691216057308f * (x + 0.044715f * x * x * x); return x * sigmoidf_(u); }
__device__ __forceinline__ float wave_sum(float v) {
#pragma unroll
    for (int o = 1; o < 64; o <<= 1) v += __shfl_xor(v, o);
    return v;
}
#define LDS_WAIT() asm volatile("s_waitcnt lgkmcnt(0)" ::: "memory")

constexpr int BM = 256, BK = 64, HALF = 128, HTB = HALF * BK * 2;
__device__ __forceinline__ int lds_byte(int r, int c) { const int st = (r >> 4) * 2 + (c >> 5), rr = r & 15, cc = c & 31, ob = rr * 64 + cc * 2; return st * 1024 + (ob ^ (((ob >> 9) & 1) << 5)); }
__device__ __forceinline__ void stage_rc(int b, int& R, int& C) { const int st = b / 1024, sb = b % 1024, swz = sb ^ (((sb >> 9) & 1) << 5); R = (st >> 1) * 16 + swz / 64; C = (st & 1) * 32 + (swz % 64) / 2; }
__device__ __forceinline__ int perm32(int rho) { const int n = rho >> 4, i = rho & 15; return 8 * (i >> 2) + 4 * n + (i & 3); }

struct Unit { int pm, pn; };
struct Gemm { const bf16_t* A; const bf16_t* Bt; int lda, ldb, K; };
struct Order {
    int mode, nM, nN, nwg, G, c;
    __device__ __forceinline__ bool next(int i, Unit& u) const {
        const int L = i * G + c; if (L >= nwg) return false;
        if (mode == 2) { const int g = L / nM, ii = L - g * nM; u.pm = g * 5 + ii; u.pn = g; return true; }
        if (mode == 3) { const int x = c & 7, j = c >> 3; u.pm = 8 * x + 4 * i + (j & 3); u.pn = j >> 2; return true; }
        if (mode == 1 && L >= 1536) { const int t = L - 1536; u.pm = 64 + (t >> 2); u.pn = 4 + (t & 3); return true; }
        const int nw = nM * nN; int wgid = L; { const int q = nw / 8, r = nw % 8, xcd = wgid % 8, off = wgid / 8; wgid = (xcd < r ? xcd * (q + 1) : r * (q + 1) + (xcd - r) * q) + off; }
        const int nig = 8 * nN, gid = wgid / nig, fm = gid * 8, gsz = (nM - fm) < 8 ? (nM - fm) : 8;
        u.pm = fm + ((wgid % nig) % gsz); u.pn = (wgid % nig) / gsz; return true;
    }
};

enum EpiMode { E_WIN = 0, E_S5A, E_S5C, E_GLU, E_AUP, E_SUP, E_WOUT, E_M1, E_M2, E_WOUTF, E_M2F };


__device__ __forceinline__ void panel_stats(const f32x4 (&v)[2][2][4][2], int pm, int pn, int wr, int wc, int fr, int fq, LAS unsigned char* lds, int wid, int lane,
                                            unsigned long long* xbuf, unsigned* cnt) {
    LAS f32x2* P = (LAS f32x2*)(lds + XL_OFF);
    LAS f32x2* S = (LAS f32x2*)(lds + XL_OFF + 8192);
#pragma unroll
    for (int ai = 0; ai < 2; ++ai)
#pragma unroll
        for (int m = 0; m < 4; ++m) {
            float s = 0.f;
#pragma unroll
            for (int bj = 0; bj < 2; ++bj)
#pragma unroll
                for (int n = 0; n < 2; ++n) { const f32x4 x = v[ai][bj][m][n]; s += (x[0] + x[1]) + (x[2] + x[3]); }
            s += __shfl_xor(s, 16); s += __shfl_xor(s, 32);
            const float mw = s * (1.0f / 64.0f); float q = 0.f;
#pragma unroll
            for (int bj = 0; bj < 2; ++bj)
#pragma unroll
                for (int n = 0; n < 2; ++n) { const f32x4 d = v[ai][bj][m][n] - mw; q += (d[0] * d[0] + d[1] * d[1]) + (d[2] * d[2] + d[3] * d[3]); }
            q += __shfl_xor(q, 16); q += __shfl_xor(q, 32);
            if (fq == 0) P[(ai * HALF + wr * 64 + m * 16 + fr) * 4 + wc] = (f32x2){mw, q};
            __builtin_amdgcn_sched_barrier(0);
        }
    asm volatile("s_waitcnt lgkmcnt(0)" ::: "memory"); __builtin_amdgcn_s_barrier(); asm volatile("" ::: "memory");
    const int row = wid * 32 + (lane & 31);
    if (lane < 32) {
        const f32x2 a = P[row * 4 + 0], b = P[row * 4 + 1], c = P[row * 4 + 2], d = P[row * 4 + 3];
        const float mt = (a.x + b.x + c.x + d.x) * 0.25f;
        const float da = a.x - mt, db = b.x - mt, dc = c.x - mt, dd = d.x - mt;
        const float m2 = (a.y + b.y) + (c.y + d.y) + 64.0f * ((da * da + db * db) + (dc * dc + dd * dd));
        unsigned long long* slot = xbuf + ((size_t)(pm * BM + row) * 8 + pn);
        __hip_atomic_store(slot, ((unsigned long long)__builtin_bit_cast(unsigned, m2) << 32) | __builtin_bit_cast(unsigned, mt), __ATOMIC_RELAXED, __HIP_MEMORY_SCOPE_AGENT);
    }
    asm volatile("s_waitcnt vmcnt(0)" ::: "memory");
    if (lane == 0) __hip_atomic_fetch_add(cnt + 64 * pm, 1u, __ATOMIC_RELAXED, __HIP_MEMORY_SCOPE_AGENT);
    if (wid == 0) {
        while ((unsigned)__builtin_amdgcn_readfirstlane(__hip_atomic_load(cnt + 64 * pm, __ATOMIC_RELAXED, __HIP_MEMORY_SCOPE_AGENT)) < 64u) __builtin_amdgcn_s_sleep(2);
        __builtin_amdgcn_fence(__ATOMIC_ACQUIRE, "agent");
    }
    asm volatile("s_waitcnt vmcnt(0) lgkmcnt(0)" ::: "memory"); __builtin_amdgcn_s_barrier(); asm volatile("" ::: "memory");
    if (lane < 32) {
        const unsigned long long* slot = xbuf + (size_t)(pm * BM + row) * 8; float mt[8], m2[8]; float ms = 0.f;
#pragma unroll
        for (int t = 0; t < 8; ++t) { const unsigned long long w = __hip_atomic_load(slot + t, __ATOMIC_RELAXED, __HIP_MEMORY_SCOPE_AGENT); mt[t] = __builtin_bit_cast(float, (unsigned)w); m2[t] = __builtin_bit_cast(float, (unsigned)(w >> 32)); ms += mt[t]; }
        const float mean = ms * 0.125f; float q = 0.f;
#pragma unroll
        for (int t = 0; t < 8; ++t) { const float dm = mt[t] - mean; q += m2[t] + 256.0f * dm * dm; }
        S[row] = (f32x2){mean, rsqrtf(q * (1.0f / DM) + LN_EPS)};
    }
    asm volatile("s_waitcnt lgkmcnt(0)" ::: "memory"); __builtin_amdgcn_s_barrier(); asm volatile("" ::: "memory");
}

template <int mode> struct Epi {
    unsigned char* ws; const float* pa; const float* pb; const float* pc; float* outp;
    __device__ __forceinline__ void operator()(f32x4 (&acc)[2][2][4][2], const Unit& u, int wr, int wc, int fr, int fq, LAS unsigned char* lds, int wid, int lane) const {
        const int row0 = u.pm * BM + wr * 64 + fr;
        const int cb = wc * 32 + 8 * fq;
        if constexpr (mode == E_M1) {
            bf16_t* O = (bf16_t*)(ws + WS_HID); const float* b1 = pa;
            f32x4 bv[2][2];
#pragma unroll
            for (int bj = 0; bj < 2; ++bj)
#pragma unroll
                for (int n = 0; n < 2; ++n) bv[bj][n] = *(const f32x4*)(b1 + u.pn * BM + bj * HALF + cb + 4 * n);
#pragma unroll
            for (int ai = 0; ai < 2; ++ai)
#pragma unroll
                for (int m = 0; m < 4; ++m) { bf16_t* rowp = O + (size_t)(row0 + ai * HALF + m * 16) * DFF + u.pn * BM + cb;
#pragma unroll
                    for (int bj = 0; bj < 2; ++bj) { f32x4 v0 = acc[ai][bj][m][0] + bv[bj][0], v1 = acc[ai][bj][m][1] + bv[bj][1];
#pragma unroll
                        for (int j = 0; j < 4; ++j) { const float a = fmaxf(v0[j], 0.f), b = fmaxf(v1[j], 0.f); v0[j] = a * a; v1[j] = b * b; }
                        u32x4 w; w.x = cvt_pk_bf16(v0[0], v0[1]); w.y = cvt_pk_bf16(v0[2], v0[3]); w.z = cvt_pk_bf16(v1[0], v1[1]); w.w = cvt_pk_bf16(v1[2], v1[3]);
                        *(u32x4*)(rowp + bj * HALF) = w; } }
        } else if constexpr (mode == E_M2 || mode == E_WOUT) {
            const bool m2 = (mode == E_M2);
            const float* base = m2 ? (const float*)outp : pa; float* out = outp;
            const float* mod = (const float*)(ws + WS_MOD) + (size_t)(u.pm >> 3) * 12288 + (m2 ? 10240 : 4096);
            const float* b2 = pa;
            f32x4 gv[2][2], bv[2][2];
#pragma unroll
            for (int bj = 0; bj < 2; ++bj)
#pragma unroll
                for (int n = 0; n < 2; ++n) { const int c = u.pn * BM + bj * HALF + cb + 4 * n; gv[bj][n] = *(const f32x4*)(mod + c);
                    bv[bj][n] = m2 ? *(const f32x4*)(b2 + c) : (f32x4){0.f, 0.f, 0.f, 0.f}; }
#pragma unroll
            for (int ai = 0; ai < 2; ++ai)
#pragma unroll
                for (int m = 0; m < 4; ++m) { const size_t ro = (size_t)(row0 + ai * HALF + m * 16) * DM + u.pn * BM + cb;
#pragma unroll
                    for (int bj = 0; bj < 2; ++bj)
#pragma unroll
                        for (int n = 0; n < 2; ++n) { const f32x4 xb = *(const f32x4*)(base + ro + bj * HALF + 4 * n);
                            const f32x4 v = xb * ALPHA_F + gv[bj][n] * (acc[ai][bj][m][n] + bv[bj][n]);
                            *(f32x4*)(out + ro + bj * HALF + 4 * n) = v; } }
        } else if constexpr (mode == E_WOUTF || mode == E_M2F) {
            constexpr bool m2 = (mode == E_M2F);
            const float* base = m2 ? (const float*)outp : pa; float* out = outp;
            const float* mod = (const float*)(ws + WS_MOD) + (size_t)(u.pm >> 3) * 12288;
            const float* gate = mod + (m2 ? 10240 : 4096);
            const float* lg = pb;
            const int c0 = u.pn * BM + cb;
#define MEMFENCE() do { asm volatile("" ::: "memory"); __builtin_amdgcn_sched_barrier(0); } while (0)
#define OPQ(p) asm volatile("" : "+v"(p))
#pragma unroll
            for (int bj = 0; bj < 2; ++bj)
#pragma unroll
                for (int n = 0; n < 2; ++n) { const int c = c0 + bj * HALF + 4 * n; const f32x4 gv = *(const f32x4*)(gate + c);
                    f32x4 bv = {0.f, 0.f, 0.f, 0.f}; if (m2) bv = *(const f32x4*)(pa + c);
                    const float* rp = base + (size_t)row0 * DM + c; OPQ(rp);
#pragma unroll
                    for (int ai = 0; ai < 2; ++ai) {
#pragma unroll
                        for (int m = 0; m < 4; ++m) { const f32x4 xb = *(const f32x4*)rp; rp += (m == 3 ? 80 : 16) * DM; OPQ(rp);
                            acc[ai][bj][m][n] = xb * ALPHA_F + gv * (acc[ai][bj][m][n] + bv); OPQ(acc[ai][bj][m][n]); }
                        MEMFENCE(); } }
            unsigned long long* xb0 = (unsigned long long*)(ws + WS_XBUF) + (size_t)(m2 ? 2 : 0) * MLAT * 8;
            unsigned* cn0 = (unsigned*)(ws + WS_CNT) + (size_t)(m2 ? 2 : 0) * 64 * 64;
            panel_stats(acc, u.pm, u.pn, wr, wc, fr, fq, lds, wid, lane, xb0, cn0);
            const LAS f32x2* S = (const LAS f32x2*)(lds + XL_OFF + 8192);
            const int rl0 = wr * 64 + fr;
#pragma unroll
            for (int bj = 0; bj < 2; ++bj)
#pragma unroll
                for (int n = 0; n < 2; ++n) { const int c = c0 + bj * HALF + 4 * n; const f32x4 lgv = *(const f32x4*)(lg + c), lbv = *(const f32x4*)(pc + c);
                    float* op = out + (size_t)row0 * DM + c; OPQ(op);
#pragma unroll
                    for (int ai = 0; ai < 2; ++ai) {
#pragma unroll
                        for (int m = 0; m < 4; ++m) { const f32x2 st = S[rl0 + ai * HALF + m * 16];
                            const f32x4 o = (acc[ai][bj][m][n] - st.x) * st.y * lgv + lbv;
                            acc[ai][bj][m][n] = o; *(f32x4*)op = o; op += (m == 3 ? 80 : 16) * DM; OPQ(op); }
                        MEMFENCE(); } }
            if constexpr (!m2) {
                panel_stats(acc, u.pm, u.pn, wr, wc, fr, fq, lds, wid, lane, xb0 + (size_t)MLAT * 8, cn0 + 64 * 64);
#pragma unroll
                for (int bj = 0; bj < 2; ++bj) { const int c = c0 + bj * HALF;
                    const f32x4 sc0 = *(const f32x4*)(mod + 4 * DM + c) + 1.f, sc1 = *(const f32x4*)(mod + 4 * DM + c + 4) + 1.f, sh0 = *(const f32x4*)(mod + 3 * DM + c), sh1 = *(const f32x4*)(mod + 3 * DM + c + 4);
                    bf16_t* hp = (bf16_t*)(ws + WS_H2) + (size_t)row0 * DM + c; OPQ(hp);
#pragma unroll
                    for (int ai = 0; ai < 2; ++ai) {
#pragma unroll
                        for (int m = 0; m < 4; ++m) { const f32x2 st = S[rl0 + ai * HALF + m * 16];
                            const f32x4 h0 = (acc[ai][bj][m][0] - st.x) * st.y * sc0 + sh0;
                            const f32x4 h1 = (acc[ai][bj][m][1] - st.x) * st.y * sc1 + sh1;
                            u32x4 w; w.x = cvt_pk_bf16(h0[0], h0[1]); w.y = cvt_pk_bf16(h0[2], h0[3]); w.z = cvt_pk_bf16(h1[0], h1[1]); w.w = cvt_pk_bf16(h1[2], h1[3]);
                            *(u32x4*)hp = w; hp += (m == 3 ? 80 : 16) * DM; OPQ(hp); }
                        MEMFENCE(); } }
            }
#undef OPQ
#undef MEMFENCE
        } else if constexpr (mode == E_AUP || mode == E_SUP) {
            const bool sup = (mode == E_SUP);
            bf16_t* MG = (bf16_t*)(ws + WS_MERG); const bf16_t* SG = (const bf16_t*)(ws + (sup ? WS_SGS : WS_SGA));
#pragma unroll
            for (int ai = 0; ai < 2; ++ai)
#pragma unroll
                for (int m = 0; m < 4; ++m) { const size_t ro = (size_t)(row0 + ai * HALF + m * 16) * DM + u.pn * BM + cb;
#pragma unroll
                    for (int bj = 0; bj < 2; ++bj) { const u32x4 g = *(const u32x4*)(SG + ro + bj * HALF);
                        f32x4 v0 = acc[ai][bj][m][0], v1 = acc[ai][bj][m][1];
                        v0[0] *= bflo(g.x); v0[1] *= bfhi(g.x); v0[2] *= bflo(g.y); v0[3] *= bfhi(g.y);
                        v1[0] *= bflo(g.z); v1[1] *= bfhi(g.z); v1[2] *= bflo(g.w); v1[3] *= bfhi(g.w);
                        if (sup) { const u32x4 o = *(const u32x4*)(MG + ro + bj * HALF);
                            v0[0] += bflo(o.x); v0[1] += bfhi(o.x); v0[2] += bflo(o.y); v0[3] += bfhi(o.y);
                            v1[0] += bflo(o.z); v1[1] += bfhi(o.z); v1[2] += bflo(o.w); v1[3] += bfhi(o.w); }
                        u32x4 w; w.x = cvt_pk_bf16(v0[0], v0[1]); w.y = cvt_pk_bf16(v0[2], v0[3]); w.z = cvt_pk_bf16(v1[0], v1[1]); w.w = cvt_pk_bf16(v1[2], v1[3]);
                        *(u32x4*)(MG + ro + bj * HALF) = w; } }
        } else if constexpr (mode == E_GLU) {
            bf16_t* O = (bf16_t*)(ws + WS_SGLU);
#pragma unroll
            for (int ai = 0; ai < 2; ++ai)
#pragma unroll
                for (int m = 0; m < 4; ++m) { bf16_t* rowp = O + (size_t)(row0 + ai * HALF + m * 16) * SW + u.pn * HALF + cb;
                    f32x4 v0, v1;
#pragma unroll
                    for (int j = 0; j < 4; ++j) { v0[j] = acc[ai][0][m][0][j] * sigmoidf_(acc[ai][1][m][0][j]); v1[j] = acc[ai][0][m][1][j] * sigmoidf_(acc[ai][1][m][1][j]); }
                    u32x4 w; w.x = cvt_pk_bf16(v0[0], v0[1]); w.y = cvt_pk_bf16(v0[2], v0[3]); w.z = cvt_pk_bf16(v1[0], v1[1]); w.w = cvt_pk_bf16(v1[2], v1[3]);
                    *(u32x4*)rowp = w; }
        } else if constexpr (mode == E_S5A) {
            float* O = (float*)(ws + WS_SLOC); const int g = u.pn, rg0 = (u.pm - 5 * g) * BM + wr * 64 + fr;
#pragma unroll
            for (int ai = 0; ai < 2; ++ai)
#pragma unroll
                for (int m = 0; m < 4; ++m) { float* rowp = O + ((size_t)g * S5ROWS + rg0 + ai * HALF + m * 16) * 256 + cb;
#pragma unroll
                    for (int bj = 0; bj < 2; ++bj)
#pragma unroll
                        for (int n = 0; n < 2; ++n) *(f32x4*)(rowp + bj * HALF + 4 * n) = acc[ai][bj][m][n]; }
        } else if constexpr (mode == E_S5C) {
            bf16_t* O = (bf16_t*)(ws + WS_SACT); const int g = u.pn, rg0 = (u.pm - 5 * g) * BM + wr * 64 + fr;
#pragma unroll
            for (int ai = 0; ai < 2; ++ai)
#pragma unroll
                for (int m = 0; m < 4; ++m) { const int rg = rg0 + ai * HALF + m * 16, b = rg >> 7, ch = rg & 127;
#pragma unroll
                    for (int bj = 0; bj < 2; ++bj) { const int t = 8 * bj + 2 * wc + (fq >> 1); const int token = b * SEQ + ch * 16 + t;
                        const f32x4 v0 = acc[ai][bj][m][0], v1 = acc[ai][bj][m][1];
                        u32x4 w; w.x = cvt_pk_bf16(gelu_tanh(v0[0]), gelu_tanh(v0[1])); w.y = cvt_pk_bf16(gelu_tanh(v0[2]), gelu_tanh(v0[3]));
                        w.z = cvt_pk_bf16(gelu_tanh(v1[0]), gelu_tanh(v1[1])); w.w = cvt_pk_bf16(gelu_tanh(v1[2]), gelu_tanh(v1[3]));
                        *(u32x4*)(O + (size_t)token * SW + g * 16 + 8 * (fq & 1)) = w; } }
        } else {
            const int pn = u.pn;
            if (pn <= 4) {
                const bool isq = pn < 4, lat = u.pm < 64;
                const float* rope = (const float*)(ws + WS_ROPE);
                const int f0 = 16 * (wc & 1) + 4 * fq;
#pragma unroll
                for (int ai = 0; ai < 2; ++ai)
#pragma unroll
                    for (int m = 0; m < 4; ++m) { const int r = row0 + ai * HALF + m * 16;
                        f32x4 c0 = {1.f, 0.f, 1.f, 0.f}, c1 = {1.f, 0.f, 1.f, 0.f};
                        size_t orow;
                        if (lat) { const int l = r & (SEQ - 1); const int posv = (wc < 2) ? (l >> 6) : (l & 63);
                            const float* rp = rope + (size_t)(posv * 32 + f0) * 2; c0 = *(const f32x4*)rp; c1 = *(const f32x4*)(rp + 4);
                            orow = isq ? (size_t)r : (size_t)((r >> 11) * KROWS + l); }
                        else { const int rc = r - MLAT; orow = (size_t)((rc >> 8) * KROWS + SEQ + (rc & 255)); }
                        const float sc = isq ? QSCALE : 1.f;
#pragma unroll
                        for (int bj = 0; bj < 2; ++bj) { const f32x4 a0 = acc[ai][bj][m][0], a1 = acc[ai][bj][m][1];
                            const float o0 = (a0[0] * c0[0] - a0[1] * c0[1]) * sc, o1 = (a0[1] * c0[0] + a0[0] * c0[1]) * sc;
                            const float o2 = (a0[2] * c0[2] - a0[3] * c0[3]) * sc, o3 = (a0[3] * c0[2] + a0[2] * c0[3]) * sc;
                            const float o4 = (a1[0] * c1[0] - a1[1] * c1[1]) * sc, o5 = (a1[1] * c1[0] + a1[0] * c1[1]) * sc;
                            const float o6 = (a1[2] * c1[2] - a1[3] * c1[3]) * sc, o7 = (a1[3] * c1[2] + a1[2] * c1[3]) * sc;
                            u32x4 w; w.x = cvt_pk_bf16(o0, o1); w.y = cvt_pk_bf16(o2, o3); w.z = cvt_pk_bf16(o4, o5); w.w = cvt_pk_bf16(o6, o7);
                            bf16_t* dst = isq ? (bf16_t*)(ws + WS_QB) + orow * QW + pn * BM + bj * HALF + cb
                                              : (bf16_t*)(ws + WS_KB) + orow * 256 + bj * HALF + cb;
                            *(u32x4*)dst = w; } }
            } else if (pn == 5) {
                bf16_t* VT = (bf16_t*)(ws + WS_VT);
#pragma unroll
                for (int ai = 0; ai < 2; ++ai)
#pragma unroll
                    for (int m = 0; m < 4; ++m) { const int r = row0 + ai * HALF + m * 16; int b, key;
                        if (u.pm < 64) { b = r >> 11; key = r & (SEQ - 1); } else { const int rc = r - MLAT; b = rc >> 8; key = SEQ + (rc & 255); }
#pragma unroll
                        for (int bj = 0; bj < 2; ++bj) { bf16_t* dst = VT + ((size_t)(b * 2 + bj) * HD + cb) * KROWS + key;
#pragma unroll
                            for (int n = 0; n < 2; ++n)
#pragma unroll
                                for (int j = 0; j < 4; ++j) dst[(size_t)(4 * n + j) * KROWS] = (bf16_t)f2bf(acc[ai][bj][m][n][j]); } }
            } else if (pn <= 7) {
                bf16_t* U = (bf16_t*)(ws + WS_U);
#pragma unroll
                for (int ai = 0; ai < 2; ++ai)
#pragma unroll
                    for (int m = 0; m < 4; ++m) { const int r = row0 + ai * HALF + m * 16; int urow, t;
                        if (u.pm < 64) { const int l = r & (SEQ - 1); urow = (r >> 11) * 128 + (l >> 4); t = l & 15; }
                        else { const int rc = r - MLAT; urow = 1024 + (rc >> 8) * 16 + ((rc & 255) >> 4); t = rc & 15; }
#pragma unroll
                        for (int bj = 0; bj < 2; ++bj) { const int g = (pn - 6) * 16 + 8 * bj + 2 * wc + (fq >> 1);
                            const f32x4 v0 = acc[ai][bj][m][0], v1 = acc[ai][bj][m][1];
                            u32x4 w; w.x = cvt_pk_bf16(v0[0], v0[1]); w.y = cvt_pk_bf16(v0[2], v0[3]); w.z = cvt_pk_bf16(v1[0], v1[1]); w.w = cvt_pk_bf16(v1[2], v1[3]);
                            *(u32x4*)(U + ((size_t)g * S5ROWS + urow) * 512 + t * 16 + 8 * (fq & 1)) = w; } }
            } else {
                const bool isa = pn < 16; bf16_t* SG = (bf16_t*)(ws + (isa ? WS_SGA : WS_SGS)); const int ct = (pn - (isa ? 8 : 16)) * BM + cb;
#pragma unroll
                for (int ai = 0; ai < 2; ++ai)
#pragma unroll
                    for (int m = 0; m < 4; ++m) { bf16_t* rowp = SG + (size_t)(row0 + ai * HALF + m * 16) * DM + ct;
#pragma unroll
                        for (int bj = 0; bj < 2; ++bj) { const f32x4 v0 = acc[ai][bj][m][0], v1 = acc[ai][bj][m][1];
                            u32x4 w; w.x = cvt_pk_bf16(sigmoidf_(v0[0]), sigmoidf_(v0[1])); w.y = cvt_pk_bf16(sigmoidf_(v0[2]), sigmoidf_(v0[3]));
                            w.z = cvt_pk_bf16(sigmoidf_(v1[0]), sigmoidf_(v1[1])); w.w = cvt_pk_bf16(sigmoidf_(v1[2]), sigmoidf_(v1[3]));
                            *(u32x4*)(rowp + bj * HALF) = w; } }
            }
        }
    }
};

template <int MODE> __device__ __forceinline__ void gemm_phase(LAS unsigned char* lds, const Gemm g, const Order& S, const Epi<MODE>& E, int tid) {
    const int wid = __builtin_amdgcn_readfirstlane(tid >> 6), lane = tid & 63, wr = wid >> 2, wc = wid & 3, fr = lane & 15, fq = lane >> 4;
    const int K = g.K, nt = K / BK;
    unsigned voffA[2], voffB[2];
#pragma unroll
    for (int i = 0; i < 2; ++i) { int R, C; stage_rc(tid * 16 + i * 8192, R, C); const int Rb = (R & ~31) + perm32(R & 31);
        voffA[i] = (unsigned)(R * g.lda + C) * 2u; voffB[i] = (unsigned)(Rb * g.ldb + C) * 2u; }
    const size_t kstep = (size_t)(BK * 2);
    const size_t hstepA = (size_t)HALF * g.lda * 2, hstepB = (size_t)HALF * g.ldb * 2;
    const size_t tstepA = 2 * hstepA, tstepB = 2 * hstepB;
    const unsigned ldsw = (unsigned)wid * 1024u;
    const int aoff = lds_byte(wr * 64 + fr, fq * 8), boff = lds_byte(wc * 32 + fr, fq * 8);
#define PG8_SA(b, h) (((b) * 2 + (h)) * HTB)
#define PG8_SB(b, h) ((4 + (b) * 2 + (h)) * HTB)
#define PG8_STAGE(bufoff, gbase, voff) do { _Pragma("unroll") for (int _i = 0; _i < 2; ++_i) \
        __builtin_amdgcn_global_load_lds((const unsigned*)((const char*)(gbase) + (voff)[_i]), (LAS unsigned*)(lds + (bufoff) + ldsw + _i * 8192), 16, 0, 0); } while (0)
#define PG8_LDA(dst, b, h) do { _Pragma("unroll") for (int m = 0; m < 4; ++m) _Pragma("unroll") for (int k = 0; k < 2; ++k) dst[m][k] = *(const LAS bf16x8*)(lds + PG8_SA(b, h) + aoff + m * 2048 + k * 1024); } while (0)
#define PG8_LDB(dst, b, h) do { _Pragma("unroll") for (int n = 0; n < 2; ++n) _Pragma("unroll") for (int k = 0; k < 2; ++k) dst[n][k] = *(const LAS bf16x8*)(lds + PG8_SB(b, h) + boff + n * 2048 + k * 1024); } while (0)
#define PG8_MMA(ai, bj, At, Bt) do { __builtin_amdgcn_s_setprio(1); _Pragma("unroll") for (int m = 0; m < 4; ++m) _Pragma("unroll") for (int n = 0; n < 2; ++n) _Pragma("unroll") for (int k = 0; k < 2; ++k) \
        acc[ai][bj][m][n] = __builtin_amdgcn_mfma_f32_16x16x32_bf16(Bt[n][k], At[m][k], acc[ai][bj][m][n], 0, 0, 0); __builtin_amdgcn_s_setprio(0); } while (0)
#define PG8_WAIT_V(n) asm volatile("s_waitcnt vmcnt(" #n ")" ::: "memory")
#define PG8_WAIT_L(n) asm volatile("s_waitcnt lgkmcnt(" #n ")" ::: "memory")
#define PG8_BAR __builtin_amdgcn_s_barrier()
#define PG8_SCHED __builtin_amdgcn_sched_barrier(0)
    Unit cur, nxt; int ui = 0;
    if (!S.next(0, cur)) return;
    f32x4 acc[2][2][4][2];
#pragma unroll
    for (int a = 0; a < 2; ++a)
#pragma unroll
        for (int b = 0; b < 2; ++b)
#pragma unroll
            for (int m = 0; m < 4; ++m)
#pragma unroll
                for (int n = 0; n < 2; ++n) acc[a][b][m][n] = (f32x4){0.f, 0.f, 0.f, 0.f};
    bf16x8 At[4][2], B0[2][2], B1[2][2];
    const char* cA = (const char*)g.A + (size_t)cur.pm * tstepA; const char* cB = (const char*)g.Bt + (size_t)cur.pn * tstepB;
    PG8_STAGE(PG8_SB(0, 0), cB, voffB); PG8_STAGE(PG8_SB(0, 1), cB + hstepB, voffB); PG8_STAGE(PG8_SA(0, 0), cA, voffA); PG8_STAGE(PG8_SA(0, 1), cA + hstepA, voffA);
    if (wr == 1) PG8_BAR;
    PG8_WAIT_V(2); PG8_BAR;
    PG8_STAGE(PG8_SB(1, 0), cB + kstep, voffB); PG8_STAGE(PG8_SA(1, 0), cA + kstep, voffA); PG8_STAGE(PG8_SB(1, 1), cB + hstepB + kstep, voffB);
    PG8_WAIT_V(6); PG8_BAR;
    for (;;) {
        const bool has_next = S.next(ui + 1, nxt);
        const char* nA = has_next ? (const char*)g.A + (size_t)nxt.pm * tstepA : cA; const char* nB = has_next ? (const char*)g.Bt + (size_t)nxt.pn * tstepB : cB;
        for (int t = 0; t < nt; t += 2) {
            const bool last = (t == nt - 2);
            const char* a1 = cA + (size_t)(t + 1) * kstep;
            const char* a2 = last ? nA : cA + (size_t)(t + 2) * kstep; const char* b2 = last ? nB : cB + (size_t)(t + 2) * kstep;
            const char* a3 = a2 + kstep; const char* b3 = b2 + kstep;
            PG8_LDB(B0, 0, 0); PG8_LDB(B1, 0, 1); PG8_SCHED; PG8_LDA(At, 0, 0); PG8_STAGE(PG8_SA(1, 1), a1 + hstepA, voffA);
            PG8_WAIT_V(8); PG8_WAIT_L(0); PG8_BAR; PG8_MMA(0, 0, At, B0); PG8_MMA(0, 1, At, B1); PG8_BAR; PG8_SCHED;
            PG8_LDA(At, 0, 1); PG8_STAGE(PG8_SB(0, 0), b2, voffB); PG8_STAGE(PG8_SB(0, 1), b2 + hstepB, voffB); PG8_STAGE(PG8_SA(0, 0), a2, voffA);
            PG8_WAIT_V(8); PG8_WAIT_L(0); PG8_BAR; PG8_MMA(1, 0, At, B0); PG8_MMA(1, 1, At, B1); PG8_BAR; PG8_SCHED;
            PG8_LDB(B0, 1, 0); PG8_LDB(B1, 1, 1); PG8_SCHED; PG8_LDA(At, 1, 0); PG8_STAGE(PG8_SA(0, 1), a2 + hstepA, voffA);
            PG8_WAIT_V(8); PG8_WAIT_L(0); PG8_BAR; PG8_MMA(0, 0, At, B0); PG8_MMA(0, 1, At, B1); PG8_BAR; PG8_SCHED;
            PG8_LDA(At, 1, 1); PG8_STAGE(PG8_SB(1, 0), b3, voffB); PG8_STAGE(PG8_SB(1, 1), b3 + hstepB, voffB); PG8_STAGE(PG8_SA(1, 0), a3, voffA);
            PG8_WAIT_V(8); PG8_WAIT_L(0); PG8_BAR; PG8_MMA(1, 0, At, B0); PG8_MMA(1, 1, At, B1); PG8_BAR; PG8_SCHED;
        }
        if (wr == 0) PG8_BAR;
        { const int l2 = lane_id(); E(acc, cur, wr, wc, l2 & 15, l2 >> 4, lds, wid, l2); }
        if (!has_next) break;
#pragma unroll
        for (int a = 0; a < 2; ++a)
#pragma unroll
            for (int b = 0; b < 2; ++b)
#pragma unroll
                for (int m = 0; m < 4; ++m)
#pragma unroll
                    for (int n = 0; n < 2; ++n) acc[a][b][m][n] = (f32x4){0.f, 0.f, 0.f, 0.f};
        cur = nxt; cA = nA; cB = nB; ++ui;
        if (wr == 1) PG8_BAR;
    }
    PG8_WAIT_V(0);
    PG8_BAR;
#undef PG8_SA
#undef PG8_SB
#undef PG8_STAGE
#undef PG8_LDA
#undef PG8_LDB
#undef PG8_MMA
#undef PG8_WAIT_V
#undef PG8_WAIT_L
#undef PG8_BAR
#undef PG8_SCHED
}

__device__ __forceinline__ int src_col(int mode, int n) {
    if (mode == 1) { if (n >= 1280) return n; const int pos = n & 127, mm = pos >> 1, sec = pos & 1; const int i = mm + ((mm >= 32) ? 32 : 0); return (n & ~127) + i + 32 * sec; }
    if (mode == 2) { const int t = n >> 8, w = n & 255; return (w < 128) ? t * 128 + w : 512 + t * 128 + (w - 128); }
    return n;
}
__device__ __forceinline__ void p0_transpose_item(const float* W, int K, int N, bf16_t* WT, int mode, LAS float* scr, int item, int lane) {
    const int nblk = N / 32, kb = item / nblk, nb = item % nblk, k0 = 64 * kb, n0 = 32 * nb;
    const int sc = src_col(mode, n0 + (lane & 31));
#pragma unroll 8
    for (int i = 0; i < 32; ++i) { const int kk = 2 * i + (lane >> 5); scr[kk * 33 + (lane & 31)] = W[(size_t)(k0 + kk) * N + sc]; }
    LDS_WAIT(); asm volatile("" ::: "memory");
    const int c = lane & 7;
#pragma unroll
    for (int j = 0; j < 4; ++j) { const int n = (lane >> 3) + 8 * j; const LAS float* s = scr + (8 * c) * 33 + n;
        u32x4 o; o.x = pk2(s[0 * 33], s[1 * 33]); o.y = pk2(s[2 * 33], s[3 * 33]); o.z = pk2(s[4 * 33], s[5 * 33]); o.w = pk2(s[6 * 33], s[7 * 33]);
        *(u32x4*)(WT + (size_t)(n0 + n) * K + k0 + 8 * c) = o; }
    LDS_WAIT(); asm volatile("" ::: "memory");
}

__device__ __forceinline__ void ada_item(LAS unsigned char* lds, int item, int tid) {
    LAS float* scv = (LAS float*)lds;
    LAS float* red = (LAS float*)(lds + 73728);
    for (int i = tid; i < 9 * DM; i += 512) { const float v = (i < 8 * DM) ? KP->in[1][i] : KP->in[3][i - 8 * DM]; scv[i] = v / (1.f + __expf(-v)); }
    __syncthreads();
    const int cl = tid & 15, kg = tid >> 4, n0 = item * 64;
    const float* w = KP->in[4] + (size_t)(kg * 64) * 12288 + n0 + 4 * cl;
    f32x4 a[9];
#pragma unroll
    for (int m = 0; m < 9; ++m) a[m] = (f32x4){0.f, 0.f, 0.f, 0.f};
#pragma unroll 4
    for (int k = 0; k < 64; ++k) { const f32x4 wv = *(const f32x4*)(w + (size_t)k * 12288);
#pragma unroll
        for (int m = 0; m < 9; ++m) a[m] += wv * scv[m * DM + kg * 64 + k]; }
#pragma unroll
    for (int m = 0; m < 9; ++m) *(LAS f32x4*)(red + (kg * 9 + m) * 64 + 4 * cl) = a[m];
    __syncthreads();
    float* MOD = (float*)(KP->ws + WS_MOD);
    for (int i = tid; i < 9 * 64; i += 512) { const int m = i >> 6, col = i & 63; float s = KP->in[5][n0 + col];
        for (int q = 0; q < 32; ++q) s += red[(q * 9 + m) * 64 + col];
        MOD[(size_t)m * 12288 + n0 + col] = s; }
    __syncthreads();
}

__device__ __forceinline__ void s5_precompute(LAS unsigned char* lds, int g, int tid) {
    LAS float* Ere = (LAS float*)lds;
    LAS float* Eim = Ere + 2176;
    LAS float* Bre = Eim + 2176;
    LAS float* Bim = Bre + 2048;
    LAS float* Cre = Bim + 2048;
    LAS float* Cim = Cre + 2048;
    LAS float* Cf = Cim + 2048;
    float* LAMT = (float*)(KP->ws + WS_LAMT);
    if (tid < 128) {
        const int dir = tid >> 6, pp = tid & 63;
        const float are = KP->in[8][(dir * 32 + g) * 64 + pp], aim = KP->in[9][(dir * 32 + g) * 64 + pp];
        const float dt = expf(KP->in[10][dir * 32 + g]);
        const float mag = expf(are * dt); float sn, cs; sincosf(aim * dt, &sn, &cs);
        const float lr = mag * cs, li = mag * sn;
        const float nr = lr - 1.f, ni = li, den = are * are + aim * aim;
        Cf[tid * 2] = (nr * are + ni * aim) / den; Cf[tid * 2 + 1] = (ni * are - nr * aim) / den;
        float er = 1.f, ei = 0.f;
        for (int d = 0; d <= 16; ++d) { Ere[tid * 17 + d] = er; Eim[tid * 17 + d] = ei;
            if (d == 16) { LAMT[((g * 2 + dir) * 2 + 0) * 64 + pp] = er; LAMT[((g * 2 + dir) * 2 + 1) * 64 + pp] = ei; }
            const float t = er * lr - ei * li; ei = er * li + ei * lr; er = t; }
    }
    __syncthreads();
    for (int idx = tid; idx < 2048; idx += 512) { const int dir = idx >> 10, pp = (idx >> 4) & 63, h = idx & 15;
        const size_t si = ((size_t)(dir * 32 + g) * 64 + pp) * 16 + h; const float br = KP->in[11][si], bi = KP->in[12][si];
        const float cr = Cf[(dir * 64 + pp) * 2], ci = Cf[(dir * 64 + pp) * 2 + 1];
        Bre[idx] = cr * br - ci * bi; Bim[idx] = cr * bi + ci * br;
        const int hh = (idx >> 6) & 15, p2 = idx & 63; const size_t ci2 = ((size_t)(dir * 32 + g) * 16 + hh) * 64 + p2;
        Cre[idx] = KP->in[13][ci2]; Cim[idx] = KP->in[14][ci2]; }
    __syncthreads();
    bf16_t* Wm = (bf16_t*)(KP->ws + WS_WMAT) + (size_t)g * 256 * 256;
    bf16_t* Mm = (bf16_t*)(KP->ws + WS_MMAT) + (size_t)g * 256 * 512;
    for (int idx = tid; idx < 65536; idx += 512) {
        {
            const int n = idx >> 8, k = idx & 255, dir = n >> 7, ri = (n >> 6) & 1, pp = n & 63, j = k >> 4, hh = k & 15, e = dir ? j : 15 - j;
            const float er = Ere[(dir * 64 + pp) * 17 + e], ei = Eim[(dir * 64 + pp) * 17 + e], br = Bre[(dir * 64 + pp) * 16 + hh], bi = Bim[(dir * 64 + pp) * 16 + hh];
            Wm[idx] = (bf16_t)f2bf(ri ? (er * bi + ei * br) : (er * br - ei * bi));
        }
        {
            const int row = idx >> 8, t = row >> 4, hh = row & 15, cc = idx & 255, dir = cc >> 7, ri = (cc >> 6) & 1, pp = cc & 63, e = dir ? 16 - t : t + 1;
            const float er = Ere[(dir * 64 + pp) * 17 + e], ei = Eim[(dir * 64 + pp) * 17 + e], cr = Cre[(dir * 16 + hh) * 64 + pp], ci = Cim[(dir * 16 + hh) * 64 + pp];
            Mm[(size_t)row * 512 + 256 + cc] = (bf16_t)f2bf(ri ? -(cr * ei + ci * er) : (cr * er - ci * ei));
        }
    }
    if (tid < 496) {
        const int dd = tid / 16 - 15, hh = tid & 15, e = dd < 0 ? -dd : dd;
        float kv[16];
#pragma unroll
        for (int q = 0; q < 16; ++q) kv[q] = 0.f;
#pragma unroll
        for (int dir = 0; dir < 2; ++dir) {
            const bool on = dir == 0 ? (dd >= 0) : (dd <= 0);
            if (on) {
                for (int pp = 0; pp < 64; ++pp) {
                    const float er = Ere[(dir * 64 + pp) * 17 + e], ei = Eim[(dir * 64 + pp) * 17 + e], cr = Cre[(dir * 16 + hh) * 64 + pp], ci = Cim[(dir * 16 + hh) * 64 + pp];
                    const float gr = cr * er - ci * ei, gi = cr * ei + ci * er;
#pragma unroll
                    for (int q = 0; q < 16; ++q) kv[q] += gr * Bre[(dir * 64 + pp) * 16 + q] - gi * Bim[(dir * 64 + pp) * 16 + q];
                }
            }
        }
        if (dd == 0) { const float dv = KP->in[15][g * 16 + hh];
#pragma unroll
            for (int q = 0; q < 16; ++q) kv[q] += (q == hh) ? dv : 0.f; }
        u32x4 w0, w1;
        w0.x = pk2(kv[0], kv[1]); w0.y = pk2(kv[2], kv[3]); w0.z = pk2(kv[4], kv[5]); w0.w = pk2(kv[6], kv[7]);
        w1.x = pk2(kv[8], kv[9]); w1.y = pk2(kv[10], kv[11]); w1.z = pk2(kv[12], kv[13]); w1.w = pk2(kv[14], kv[15]);
        for (int t = 0; t < 16; ++t) { const int j = t - dd; if (j >= 0 && j < 16) { bf16_t* dst = Mm + (size_t)(t * 16 + hh) * 512 + j * 16; *(u32x4*)dst = w0; *(u32x4*)(dst + 8) = w1; } }
    }
    __syncthreads();
}

__device__ __forceinline__ void step_prologue(LAS unsigned char* lds, int tid) {
    const int lane = tid & 63, wave = tid >> 6;
    for (int it = blockIdx.x; it < 225; it += gridDim.x) {
        if (it < 32) s5_precompute(lds, it, tid);
        else if (it < 224) ada_item(lds, it - 32, tid);
        else { float* rope = (float*)(KP->ws + WS_ROPE);
            for (int idx = tid; idx < 2048; idx += 512) { const int pos = idx >> 5, f = idx & 31; const float fr_ = powf(10000.f, -(float)f / 32.f); const float ang = (float)pos * fr_;
                rope[idx * 2] = cosf(ang); rope[idx * 2 + 1] = sinf(ang); } }
    }
    __syncthreads();
    LAS float* scr = (LAS float*)(lds + wave * 16384);
    const int gw = blockIdx.x * 8 + wave, NGW = gridDim.x * 8;
    constexpr int I_IN = 32 * 192, I_GLU = 8 * 32, I_AUP = 16 * 64, I_SUP = 8 * 64, I_OUT = 32 * 64, I_M1 = 32 * 256, I_M2 = 128 * 64;
    constexpr int NITEMS = I_IN + I_GLU + I_AUP + I_SUP + I_OUT + I_M1 + I_M2;
    unsigned char* ws = KP->ws;
    for (int it = gw; it < NITEMS; it += NGW) {
        int r = it;
        if (r < I_IN) { p0_transpose_item(KP->in[6], DM, INC, (bf16_t*)(ws + WS_WTIN), 1, scr, r, lane); continue; } r -= I_IN;
        if (r < I_GLU) { p0_transpose_item(KP->in[16], SW, 2 * SW, (bf16_t*)(ws + WS_WTGLU), 2, scr, r, lane); continue; } r -= I_GLU;
        if (r < I_AUP) { p0_transpose_item(KP->in[17], QW, DM, (bf16_t*)(ws + WS_WTAUP), 0, scr, r, lane); continue; } r -= I_AUP;
        if (r < I_SUP) { p0_transpose_item(KP->in[18], SW, DM, (bf16_t*)(ws + WS_WTSUP), 0, scr, r, lane); continue; } r -= I_SUP;
        if (r < I_OUT) { p0_transpose_item(KP->in[19], DM, DM, (bf16_t*)(ws + WS_WTOUT), 0, scr, r, lane); continue; } r -= I_OUT;
        if (r < I_M1) { p0_transpose_item(KP->in[22], DM, DFF, (bf16_t*)(ws + WS_WTM1), 0, scr, r, lane); continue; } r -= I_M1;
        p0_transpose_item(KP->in[24], DFF, DM, (bf16_t*)(ws + WS_WTM2), 0, scr, r, lane);
    }
}

__device__ __forceinline__ void ln_stats(const f32x4 (&v)[8], float& mean, float& rstd) {
    float s = 0.f;
#pragma unroll
    for (int j = 0; j < 8; ++j) s += (v[j][0] + v[j][1]) + (v[j][2] + v[j][3]);
    mean = wave_sum(s) * (1.f / DM); float q = 0.f;
#pragma unroll
    for (int j = 0; j < 8; ++j) { const f32x4 d = v[j] - mean; q += (d[0] * d[0] + d[1] * d[1]) + (d[2] * d[2] + d[3] * d[3]); }
    rstd = rsqrtf(wave_sum(q) * (1.f / DM) + LN_EPS);
}
__device__ __forceinline__ void step_ln1(int tid) {
    const int lane = tid & 63, gw = blockIdx.x * 8 + (tid >> 6), NGW = gridDim.x * 8;
    const float* MOD = (const float*)(KP->ws + WS_MOD); bf16_t* H = (bf16_t*)(KP->ws + WS_HALL);
    for (int r = gw; r < MALL; r += NGW) {
        const float* src = (r < MLAT) ? KP->in[0] + (size_t)r * DM : KP->in[2] + (size_t)(r - MLAT) * DM;
        const float* md = MOD + (size_t)((r < MLAT) ? (r >> 11) : 8) * 12288;
        f32x4 v[8];
#pragma unroll
        for (int j = 0; j < 8; ++j) v[j] = *(const f32x4*)(src + 4 * (lane + 64 * j));
        float mean, rstd; ln_stats(v, mean, rstd);
#pragma unroll
        for (int j = 0; j < 8; ++j) { const int c = 4 * (lane + 64 * j); const f32x4 sh = *(const f32x4*)(md + c), sc = *(const f32x4*)(md + DM + c);
            const f32x4 o = (v[j] - mean) * rstd * (sc + 1.f) + sh;
            u32x2 w; w.x = cvt_pk_bf16(o[0], o[1]); w.y = cvt_pk_bf16(o[2], o[3]); *(u32x2*)(H + (size_t)r * DM + c) = w; }
    }
}
__device__ __forceinline__ void step_ln2(int tid) {
    const int lane = tid & 63, gw = blockIdx.x * 8 + (tid >> 6), NGW = gridDim.x * 8;
    const float* MOD = (const float*)(KP->ws + WS_MOD); bf16_t* H = (bf16_t*)(KP->ws + WS_H2);
    const float* lg = KP->in[20]; const float* lb = KP->in[21];
    for (int r = gw; r < MLAT; r += NGW) {
        float* row = KP->out + (size_t)r * DM; const float* md = MOD + (size_t)(r >> 11) * 12288;
        f32x4 v[8];
#pragma unroll
        for (int j = 0; j < 8; ++j) v[j] = *(const f32x4*)(row + 4 * (lane + 64 * j));
        float mean, rstd; ln_stats(v, mean, rstd);
#pragma unroll
        for (int j = 0; j < 8; ++j) { const int c = 4 * (lane + 64 * j); v[j] = (v[j] - mean) * rstd * *(const f32x4*)(lg + c) + *(const f32x4*)(lb + c); *(f32x4*)(row + c) = v[j]; }
        ln_stats(v, mean, rstd);
#pragma unroll
        for (int j = 0; j < 8; ++j) { const int c = 4 * (lane + 64 * j); const f32x4 sh = *(const f32x4*)(md + 3 * DM + c), sc = *(const f32x4*)(md + 4 * DM + c);
            const f32x4 o = (v[j] - mean) * rstd * (sc + 1.f) + sh;
            u32x2 w; w.x = cvt_pk_bf16(o[0], o[1]); w.y = cvt_pk_bf16(o[2], o[3]); *(u32x2*)(H + (size_t)r * DM + c) = w; }
    }
}
__device__ __forceinline__ void step_ln3(int tid) {
    const int lane = tid & 63, gw = blockIdx.x * 8 + (tid >> 6), NGW = gridDim.x * 8;
    const float* lg = KP->in[26]; const float* lb = KP->in[27];
    for (int r = gw; r < MLAT; r += NGW) {
        float* row = KP->out + (size_t)r * DM;
        f32x4 v[8];
#pragma unroll
        for (int j = 0; j < 8; ++j) v[j] = *(const f32x4*)(row + 4 * (lane + 64 * j));
        float mean, rstd; ln_stats(v, mean, rstd);
#pragma unroll
        for (int j = 0; j < 8; ++j) { const int c = 4 * (lane + 64 * j); *(f32x4*)(row + c) = (v[j] - mean) * rstd * *(const f32x4*)(lg + c) + *(const f32x4*)(lb + c); }
    }
}

constexpr int KS_PITCH = 272, VT_PITCH = 144, VT_OFF = 64 * KS_PITCH;
__device__ __forceinline__ void step_attn(LAS unsigned char* lds, int tid) {
    const int w = tid >> 6, lane = tid & 63, fr = lane & 15, fq = lane >> 4;
    const bf16_t* Qb = (const bf16_t*)(KP->ws + WS_QB); const bf16_t* Kb = (const bf16_t*)(KP->ws + WS_KB); const bf16_t* Vtg = (const bf16_t*)(KP->ws + WS_VT);
    bf16_t* AO = (bf16_t*)(KP->ws + WS_ATTN);
    for (int item = blockIdx.x; item < 512; item += gridDim.x) {
        const int hp = item & 1, n = (item >> 1) & 15, kvh = (item >> 5) & 1, b = item >> 6;
        const int head = kvh * 4 + hp * 2 + (w >> 2);
        const int q0 = n * 128 + (w & 3) * 32;
        bf16x8 qf[2][4];
#pragma unroll
        for (int qb = 0; qb < 2; ++qb)
#pragma unroll
            for (int ks = 0; ks < 4; ++ks) qf[qb][ks] = *(const bf16x8*)(Qb + (size_t)(b * SEQ + q0 + 16 * qb + fr) * QW + head * HD + 32 * ks + 8 * fq);
        const float sk = KP->in[7][head] * LOG2E;
        float m_[2] = {sk, sk}, l_[2]; l_[0] = l_[1] = (fq == 0) ? 1.f : 0.f;
        f32x4 o[2][8];
#pragma unroll
        for (int qb = 0; qb < 2; ++qb)
#pragma unroll
            for (int db = 0; db < 8; ++db) o[qb][db] = (f32x4){0.f, 0.f, 0.f, 0.f};
        const int tb_lo = (n == 0) ? 2 : 0, tb_hi = (n == 15) ? 4 : 6, nbt = tb_hi - tb_lo, ntile = nbt + 4;
        const bf16_t* kbase = Kb + (size_t)b * KROWS * 256 + kvh * HD;
        const bf16_t* vbase = Vtg + (size_t)(b * 2 + kvh) * HD * KROWS;
        u32x4 kr[2], vr[2];
        {   const int krow0 = 128 * (n - 1) + 64 * tb_lo;
#pragma unroll
            for (int i = 0; i < 2; ++i) { const int c = tid + 512 * i; kr[i] = *(const u32x4*)(kbase + (size_t)(krow0 + (c >> 4)) * 256 + (c & 15) * 8);
                vr[i] = *(const u32x4*)(vbase + (size_t)(c >> 3) * KROWS + krow0 + (c & 7) * 8); } }
        for (int t = 0; t < ntile; ++t) {
            __syncthreads();
#pragma unroll
            for (int i = 0; i < 2; ++i) { const int c = tid + 512 * i; *(LAS u32x4*)(lds + (c >> 4) * KS_PITCH + (c & 15) * 16) = kr[i];
                *(LAS u32x4*)(lds + VT_OFF + (c >> 3) * VT_PITCH + (c & 7) * 16) = vr[i]; }
            __syncthreads();
            const bool band = t < nbt;
            const int kp0 = band ? 128 * (n - 1) + 64 * (tb_lo + t) : 0;
            if (t + 1 < ntile) { const int t1 = t + 1; const int krow0 = (t1 < nbt) ? 128 * (n - 1) + 64 * (tb_lo + t1) : SEQ + 64 * (t1 - nbt);
#pragma unroll
                for (int i = 0; i < 2; ++i) { const int c = tid + 512 * i; kr[i] = *(const u32x4*)(kbase + (size_t)(krow0 + (c >> 4)) * 256 + (c & 15) * 8);
                    vr[i] = *(const u32x4*)(vbase + (size_t)(c >> 3) * KROWS + krow0 + (c & 7) * 8); } }
            if (band && (kp0 + 63 < q0 - 128 || kp0 > q0 + 31 + 128)) continue;
            f32x4 s[4][2];
#pragma unroll
            for (int kb = 0; kb < 4; ++kb)
#pragma unroll
                for (int qb = 0; qb < 2; ++qb) s[kb][qb] = (f32x4){0.f, 0.f, 0.f, 0.f};
#pragma unroll
            for (int kb = 0; kb < 4; ++kb)
#pragma unroll
                for (int ks = 0; ks < 4; ++ks) { const bf16x8 kf = *(const LAS bf16x8*)(lds + (16 * kb + fr) * KS_PITCH + (32 * ks + 8 * fq) * 2);
#pragma unroll
                    for (int qb = 0; qb < 2; ++qb) s[kb][qb] = __builtin_amdgcn_mfma_f32_16x16x32_bf16(kf, qf[qb][ks], s[kb][qb], 0, 0, 0); }
            if (band) {
#pragma unroll
                for (int kb = 0; kb < 4; ++kb)
#pragma unroll
                    for (int qb = 0; qb < 2; ++qb)
#pragma unroll
                        for (int r = 0; r < 4; ++r) { const int dq = (q0 + 16 * qb + fr) - (kp0 + 16 * kb + 4 * fq + r); if (dq > 128 || dq < -128) s[kb][qb][r] = -1e30f; }
            }
            bf16x8 pa[2][2];
#pragma unroll
            for (int qb = 0; qb < 2; ++qb) {
                float mx = s[0][qb][0];
#pragma unroll
                for (int kb = 0; kb < 4; ++kb)
#pragma unroll
                    for (int r = 0; r < 4; ++r) mx = fmaxf(mx, s[kb][qb][r]);
                mx = fmaxf(mx, __shfl_xor(mx, 16)); mx = fmaxf(mx, __shfl_xor(mx, 32));
                const float mn = fmaxf(m_[qb], mx), alpha = exp2f(m_[qb] - mn); m_[qb] = mn;
                float rs = 0.f;
#pragma unroll
                for (int kb = 0; kb < 4; ++kb)
#pragma unroll
                    for (int r = 0; r < 4; ++r) { const float pv = exp2f(s[kb][qb][r] - mn); rs += pv; s[kb][qb][r] = pv; }
                l_[qb] = l_[qb] * alpha + rs;
#pragma unroll
                for (int r = 0; r < 4; ++r) { const float ar = __shfl(alpha, 4 * fq + r);
#pragma unroll
                    for (int db = 0; db < 8; ++db) o[qb][db][r] *= ar; }
#pragma unroll
                for (int kk = 0; kk < 2; ++kk) { u32x4 w4; w4.x = cvt_pk_bf16(s[2 * kk][qb][0], s[2 * kk][qb][1]); w4.y = cvt_pk_bf16(s[2 * kk][qb][2], s[2 * kk][qb][3]);
                    w4.z = cvt_pk_bf16(s[2 * kk + 1][qb][0], s[2 * kk + 1][qb][1]); w4.w = cvt_pk_bf16(s[2 * kk + 1][qb][2], s[2 * kk + 1][qb][3]);
                    pa[qb][kk] = __builtin_bit_cast(bf16x8, w4); }
            }
#pragma unroll
            for (int kk = 0; kk < 2; ++kk)
#pragma unroll
                for (int db = 0; db < 8; ++db) { const LAS unsigned char* vp = lds + VT_OFF + (16 * db + fr) * VT_PITCH + (32 * kk + 4 * fq) * 2;
                    const u32x2 lo = *(const LAS u32x2*)vp, hi = *(const LAS u32x2*)(vp + 32);
                    u32x4 v4; v4.x = lo.x; v4.y = lo.y; v4.z = hi.x; v4.w = hi.y; const bf16x8 vf = __builtin_bit_cast(bf16x8, v4);
#pragma unroll
                    for (int qb = 0; qb < 2; ++qb) o[qb][db] = __builtin_amdgcn_mfma_f32_16x16x32_bf16(pa[qb][kk], vf, o[qb][db], 0, 0, 0); }
        }
#pragma unroll
        for (int qb = 0; qb < 2; ++qb) { float lt = l_[qb]; lt += __shfl_xor(lt, 16); lt += __shfl_xor(lt, 32); const float inv = 1.f / lt;
#pragma unroll
            for (int r = 0; r < 4; ++r) { const float ir = __shfl(inv, 4 * fq + r); bf16_t* dst = AO + (size_t)(b * SEQ + q0 + 16 * qb + 4 * fq + r) * QW + head * HD + fr;
#pragma unroll
                for (int db = 0; db < 8; ++db) dst[16 * db] = (bf16_t)f2bf(o[qb][db][r] * ir); } }
    }
    __syncthreads();
}

__device__ __forceinline__ void step_scan(int tid) {
    if (tid >= 128) return;
    const int idx = blockIdx.x * 128 + tid; if (idx >= 32768) return;
    const int pp = idx & 63, dir = (idx >> 6) & 1, b = (idx >> 7) & 7, g = idx >> 10;
    const float* LAMT = (const float*)(KP->ws + WS_LAMT);
    const float lr = LAMT[((g * 2 + dir) * 2 + 0) * 64 + pp], li = LAMT[((g * 2 + dir) * 2 + 1) * 64 + pp];
    const float* SL = (const float*)(KP->ws + WS_SLOC) + (size_t)g * S5ROWS * 256 + dir * 128 + pp;
    bf16_t* U = (bf16_t*)(KP->ws + WS_U) + (size_t)g * S5ROWS * 512 + 256 + dir * 128 + pp;
    float sr = 0.f, si = 0.f;
    for (int c0 = 0; c0 < 144; c0 += 16) {
        float xr[16], xi[16];
#pragma unroll
        for (int q = 0; q < 16; ++q) { const int s = c0 + q; int row;
            if (s < 16) row = 1024 + b * 16 + (dir ? 15 - s : s); else row = b * 128 + (dir ? 127 - (s - 16) : (s - 16));
            xr[q] = SL[(size_t)row * 256]; xi[q] = SL[(size_t)row * 256 + 64]; }
#pragma unroll
        for (int q = 0; q < 16; ++q) { const int s = c0 + q;
            if (s >= 16) { const int row = b * 128 + (dir ? 127 - (s - 16) : (s - 16)); U[(size_t)row * 512] = (bf16_t)f2bf(sr); U[(size_t)row * 512 + 64] = (bf16_t)f2bf(si); }
            const float t = lr * sr - li * si + xr[q]; si = lr * si + li * sr + xi[q]; sr = t; }
    }
}

constexpr size_t WS_BAR = 0;
__device__ __forceinline__ void grid_bar(unsigned* ctr, unsigned target, bool leader) {
    asm volatile("s_waitcnt vmcnt(0)" ::: "memory");
    __syncthreads();
    if (leader) {
        __builtin_amdgcn_fence(__ATOMIC_RELEASE, "agent");
        asm volatile("s_waitcnt vmcnt(0)" ::: "memory");
        __hip_atomic_fetch_add(ctr, 1u, __ATOMIC_RELAXED, __HIP_MEMORY_SCOPE_AGENT);
        while (__hip_atomic_load(ctr, __ATOMIC_RELAXED, __HIP_MEMORY_SCOPE_AGENT) < target) __builtin_amdgcn_s_sleep(1);
        __builtin_amdgcn_fence(__ATOMIC_ACQUIRE, "agent");
        asm volatile("s_waitcnt vmcnt(0)" ::: "memory");
    }
    __syncthreads();
}

__global__ void __launch_bounds__(512, 2) fwd_kernel(Params p) {
    __builtin_assume(__builtin_amdgcn_workitem_id_y() == 0); __builtin_assume(__builtin_amdgcn_workitem_id_z() == 0);
    extern __shared__ __attribute__((aligned(16))) unsigned char lds_raw[];
    LAS unsigned char* lds = (LAS unsigned char*)lds_raw;
    unsigned char* ws = KP->ws;
    const int G = gridDim.x, c = blockIdx.x, lo = KP->lo, hi = KP->hi;
    const int wave_ = __builtin_amdgcn_readfirstlane(threadIdx.x >> 6);
#define TID (wave_ * 64 + lane_id())
#define IN(k) (lo <= (k) && (k) < hi)
    unsigned nbar = 0;
#define SEAM(k) do { if (IN(k) && IN((k) + 1)) { if ((k) == 0) cg::this_grid().sync(); else { ++nbar; grid_bar((unsigned*)(ws + WS_BAR), nbar * (unsigned)G, wave_ == 0 && lane_id() == 0); } } } while (0)
#define LSEAM(k) do { if (IN(k) && IN((k) + 1)) __syncthreads(); } while (0)
#define GEMM_STEP(k, MODE, Aoff, Boff, LDA, LDB, KK, OM, NM_, NN_, NWG, PA, PB, PC, OUTP) \
    if (IN(k)) for (int rep_ = 0; rep_ <= ((PROBE_MASK >> (k)) & 1); ++rep_) { const Gemm g{(const bf16_t*)(ws + (Aoff)), (const bf16_t*)(ws + (Boff)), LDA, LDB, KK}; const Order S{OM, NM_, NN_, NWG, G, c}; \
        const Epi<MODE> E{ws, PA, PB, PC, OUTP}; gemm_phase<MODE>(lds, g, S, E, TID); }
    if (IN(0)) for (int rep_ = 0; rep_ <= ((PROBE_MASK >> 0) & 1); ++rep_) { step_prologue(lds, TID); __syncthreads(); }
    SEAM(0);
    if (IN(1)) for (int rep_ = 0; rep_ <= ((PROBE_MASK >> 1) & 1); ++rep_) { step_ln1(TID); __syncthreads(); }
    SEAM(1);
    GEMM_STEP(2, E_WIN, WS_HALL, WS_WTIN, DM, DM, DM, 1, 64, 24, 1568, nullptr, nullptr, nullptr, nullptr)
    SEAM(2);
    if (IN(3)) for (int rep_ = 0; rep_ <= ((PROBE_MASK >> 3) & 1); ++rep_) { step_attn(lds, TID); __syncthreads(); }
    LSEAM(3);
    GEMM_STEP(4, E_S5A, WS_U, WS_WMAT, 512, 256, 256, 2, 5, 1, 160, nullptr, nullptr, nullptr, nullptr)
    SEAM(4);
    if (IN(5)) for (int rep_ = 0; rep_ <= ((PROBE_MASK >> 5) & 1); ++rep_) { step_scan(TID); __syncthreads(); }
    SEAM(5);
    GEMM_STEP(6, E_S5C, WS_U, WS_MMAT, 512, 512, 512, 2, 4, 1, 128, nullptr, nullptr, nullptr, nullptr)
    SEAM(6);
    GEMM_STEP(7, E_GLU, WS_SACT, WS_WTGLU, SW, SW, SW, 0, 64, 4, 256, nullptr, nullptr, nullptr, nullptr)
    SEAM(7);
    GEMM_STEP(8, E_AUP, WS_ATTN, WS_WTAUP, QW, QW, QW, 0, 64, 8, 512, nullptr, nullptr, nullptr, nullptr)
    LSEAM(8);
    GEMM_STEP(9, E_SUP, WS_SGLU, WS_WTSUP, SW, SW, SW, 0, 64, 8, 512, nullptr, nullptr, nullptr, nullptr)
    SEAM(9);
    const bool fused = (N_LAUNCH_MODE == 1) && (G == 256);
    if (fused) { GEMM_STEP(10, E_WOUTF, WS_MERG, WS_WTOUT, DM, DM, DM, 3, 64, 8, 512, KP->in[0], KP->in[20], KP->in[21], KP->out) }
    else { GEMM_STEP(10, E_WOUT, WS_MERG, WS_WTOUT, DM, DM, DM, 0, 64, 8, 512, KP->in[0], nullptr, nullptr, KP->out) }
    SEAM(10);
    if (!fused) { if (IN(11)) step_ln2(TID);
    SEAM(11); }
    GEMM_STEP(12, E_M1, WS_H2, WS_WTM1, DM, DM, DM, 0, 64, 32, 2048, KP->in[23], nullptr, nullptr, nullptr)
    SEAM(12);
    if (fused) { GEMM_STEP(13, E_M2F, WS_HID, WS_WTM2, DFF, DFF, DFF, 3, 64, 8, 512, KP->in[25], KP->in[26], KP->in[27], KP->out) }
    else { GEMM_STEP(13, E_M2, WS_HID, WS_WTM2, DFF, DFF, DFF, 0, 64, 8, 512, KP->in[25], nullptr, nullptr, KP->out)
    SEAM(13);
    if (IN(14)) step_ln3(TID); }
#undef IN
#undef TID
#undef SEAM
#undef LSEAM
#undef GEMM_STEP
}

extern "C" void kernel_launch(void* const* d_in, const int* in_sizes, int n_in, void* d_out, int out_size, void* d_ws, size_t ws_size, hipStream_t stream) {
    static int grid = 0;
    if (grid == 0) {
        if (n_in != 28 || out_size != MLAT * DM || ws_size < WS_NEED) { fprintf(stderr, "kernel_launch: unexpected shapes (n_in %d out %d ws %zu)\n", n_in, out_size, ws_size); grid = -1; return; }
        int dev = 0, cus = 0, per_cu = 0;
        hipGetDevice(&dev); hipDeviceGetAttribute(&cus, hipDeviceAttributeMultiprocessorCount, dev);
        if (hipFuncSetAttribute((const void*)fwd_kernel, hipFuncAttributeMaxDynamicSharedMemorySize, LDS_BYTES) != hipSuccess) { fprintf(stderr, "kernel_launch: hipFuncSetAttribute failed\n"); grid = -1; return; }
        if (hipOccupancyMaxActiveBlocksPerMultiprocessor(&per_cu, (const void*)fwd_kernel, 512, LDS_BYTES) != hipSuccess || per_cu < 1) { fprintf(stderr, "kernel_launch: occupancy query gives %d\n", per_cu); (void)hipGetLastError(); per_cu = 1; }
        grid = cus;
        if (grid <= 0) grid = 256;
    }
    if (grid < 0) return;
    Params p{};
    for (int i = 0; i < 28; ++i) p.in[i] = (const float*)d_in[i];
    p.out = (float*)d_out; p.ws = (unsigned char*)d_ws;
#if N_LAUNCH_MODE == 1
    if (hipMemsetAsync((char*)d_ws + WS_BAR, 0, WS_CTL_BYTES, stream) != hipSuccess) { fprintf(stderr, "kernel_launch: memset failed\n"); return; }
    p.lo = 0; p.hi = NSTEPS;
    void* args[] = {&p};
    hipError_t e = hipLaunchCooperativeKernel((const void*)fwd_kernel, dim3(grid), dim3(512), args, LDS_BYTES, stream);
    if (e != hipSuccess) fprintf(stderr, "cooperative launch failed: %s (grid %d)\n", hipGetErrorString(e), grid);
#else
    for (int st = 0; st < NSTEPS; ++st) {
        p.lo = st; p.hi = st + 1;
        hipLaunchKernelGGL(fwd_kernel, dim3(grid), dim3(512), LDS_BYTES, stream, p);
    }
#endif
}
```

```cpp
#include <hip/hip_runtime.h>
#include <hip/hip_cooperative_groups.h>
#include <cstdio>
#include <cstdint>
namespace cg = cooperative_groups;

#ifndef N_LAUNCH_MODE
#define N_LAUNCH_MODE 1
#endif

#ifndef PROBE_MASK
#define PROBE_MASK 0
#endif
#define LAS __attribute__((address_space(3)))
typedef unsigned short bf16_t;
typedef short bf16x8 __attribute__((ext_vector_type(8)));
typedef float f32x4 __attribute__((ext_vector_type(4)));
typedef float f32x2 __attribute__((ext_vector_type(2)));
typedef unsigned u32x4 __attribute__((ext_vector_type(4)));
typedef unsigned u32x2 __attribute__((ext_vector_type(2)));

constexpr int DM = 2048, NB = 8, SEQ = 2048, CTXL = 256, HD = 128, NH = 8;
constexpr int QW = 1024, SW = 512, INC = 6144, DFF = 8192;
constexpr int MLAT = NB * SEQ, MCTX = NB * CTXL, MALL = MLAT + MCTX;
constexpr int KROWS = SEQ + CTXL;
constexpr int S5ROWS = 1280;
constexpr float ALPHA_F = 1.189207115002721f;
constexpr float LN_EPS = 1e-6f;
constexpr float LOG2E = 1.4426950408889634f;
constexpr float QSCALE = 0.08838834764831845f * LOG2E;
constexpr int NSTEPS = 15;

constexpr size_t MiB = 1u << 20;
constexpr size_t WS_WTIN = 1 * MiB, WS_WTGLU = 25 * MiB, WS_WTAUP = 26 * MiB, WS_WTSUP = 30 * MiB, WS_WTOUT = 32 * MiB, WS_WTM1 = 40 * MiB, WS_WTM2 = 72 * MiB;
constexpr size_t WS_WMAT = 104 * MiB, WS_MMAT = 108 * MiB, WS_MOD = 116 * MiB, WS_ROPE = 117 * MiB, WS_LAMT = 117 * MiB + 512 * 1024;
constexpr size_t WS_HALL = 128 * MiB;
constexpr size_t WS_ATTN = 128 * MiB;
constexpr size_t WS_SLOC = 160 * MiB;
constexpr size_t WS_QB = 200 * MiB, WS_KB = 232 * MiB, WS_VT = 241 * MiB;
constexpr size_t WS_SACT = 250 * MiB;
constexpr size_t WS_MERG = 200 * MiB;
constexpr size_t WS_U = 266 * MiB;
constexpr size_t WS_SGA = 306 * MiB, WS_SGS = 370 * MiB;
constexpr size_t WS_SGLU = 434 * MiB;
constexpr size_t WS_HID = 128 * MiB;
constexpr size_t WS_H2 = 384 * MiB;
constexpr size_t WS_XBUF = 118 * MiB;
constexpr size_t WS_CNT = 4096;
constexpr size_t WS_CTL_BYTES = 65536;
constexpr int XL_OFF = 131072;
constexpr size_t WS_NEED = 450 * MiB;

constexpr int LDS_BYTES = 147456;

struct Params { const float* in[28]; float* out; unsigned char* ws; int lo, hi; };
#define KP ((const __attribute__((address_space(4))) Params*)__builtin_amdgcn_kernarg_segment_ptr())
__device__ __forceinline__ int lane_id() { int l; asm volatile("v_mbcnt_lo_u32_b32 %0, -1, 0\n\tv_mbcnt_hi_u32_b32 %0, -1, %0" : "=v"(l)); return l; }

__device__ __forceinline__ unsigned f2bf(float f) { unsigned u = __builtin_bit_cast(unsigned, f); return (u + 0x7fffu + ((u >> 16) & 1u)) >> 16; }
__device__ __forceinline__ unsigned pk2(float lo, float hi) { return f2bf(lo) | (f2bf(hi) << 16); }
__device__ __forceinline__ unsigned cvt_pk_bf16(float lo, float hi) { unsigned r; asm volatile("v_cvt_pk_bf16_f32 %0, %1, %2" : "=v"(r) : "v"(lo), "v"(hi)); return r; }
__device__ __forceinline__ float bflo(unsigned w) { return __builtin_bit_cast(float, w << 16); }
__device__ __forceinline__ float bfhi(unsigned w) { return __builtin_bit_cast(float, w & 0xffff0000u); }
__device__ __forceinline__ float sigmoidf_(float x) { return 1.f / (1.f + __expf(-x)); }
__device__ __forceinline__ float gelu_tanh(float x) { const float u = 1.5957691216057308f * (x + 0.044715f * x * x * x); return x * sigmoidf_(u); }
__device__ __forceinline__ float wave_sum(float v) {
#pragma unroll
    for (int o = 1; o < 64; o <<= 1) v += __shfl_xor(v, o);
    return v;
}
#define LDS_WAIT() asm volatile("s_waitcnt lgkmcnt(0)" ::: "memory")

constexpr int BM = 256, BK = 64, HALF = 128, HTB = HALF * BK * 2;
__device__ __forceinline__ int lds_byte(int r, int c) { const int st = (r >> 4) * 2 + (c >> 5), rr = r & 15, cc = c & 31, ob = rr * 64 + cc * 2; return st * 1024 + (ob ^ (((ob >> 9) & 1) << 5)); }
__device__ __forceinline__ void stage_rc(int b, int& R, int& C) { const int st = b / 1024, sb = b % 1024, swz = sb ^ (((sb >> 9) & 1) << 5); R = (st >> 1) * 16 + swz / 64; C = (st & 1) * 32 + (swz % 64) / 2; }
__device__ __forceinline__ int perm32(int rho) { const int n = rho >> 4, i = rho & 15; return 8 * (i >> 2) + 4 * n + (i & 3); }

struct Unit { int pm, pn; };
struct Gemm { const bf16_t* A; const bf16_t* Bt; int lda, ldb, K; };
struct Order {
    int mode, nM, nN, nwg, G, c;
    __device__ __forceinline__ bool next(int i, Unit& u) const {
        const int L = i * G + c; if (L >= nwg) return false;
        if (mode == 2) { const int g = L / nM, ii = L - g * nM; u.pm = g * 5 + ii; u.pn = g; return true; }
        if (mode == 3) { const int x = c & 7, j = c >> 3; u.pm = 8 * x + 4 * i + (j & 3); u.pn = j >> 2; return true; }
        if (mode == 1 && L >= 1536) { const int t = L - 1536; u.pm = 64 + (t >> 2); u.pn = 4 + (t & 3); return true; }
        const int nw = nM * nN; int wgid = L; { const int q = nw / 8, r = nw % 8, xcd = wgid % 8, off = wgid / 8; wgid = (xcd < r ? xcd * (q + 1) : r * (q + 1) + (xcd - r) * q) + off; }
        const int nig = 8 * nN, gid = wgid / nig, fm = gid * 8, gsz = (nM - fm) < 8 ? (nM - fm) : 8;
        u.pm = fm + ((wgid % nig) % gsz); u.pn = (wgid % nig) / gsz; return true;
    }
};

enum EpiMode { E_WIN = 0, E_S5A, E_S5C, E_GLU, E_AUP, E_SUP, E_WOUT, E_M1, E_M2, E_WOUTF, E_M2F };


__device__ __forceinline__ void panel_stats(const f32x4 (&v)[2][2][4][2], int pm, int pn, int wr, int wc, int fr, int fq, LAS unsigned char* lds, int wid, int lane,
                                            unsigned long long* xbuf, unsigned* cnt) {
    LAS f32x2* P = (LAS f32x2*)(lds + XL_OFF);
    LAS f32x2* S = (LAS f32x2*)(lds + XL_OFF + 8192);
#pragma unroll
    for (int ai = 0; ai < 2; ++ai)
#pragma unroll
        for (int m = 0; m < 4; ++m) {
            float s = 0.f;
#pragma unroll
            for (int bj = 0; bj < 2; ++bj)
#pragma unroll
                for (int n = 0; n < 2; ++n) { const f32x4 x = v[ai][bj][m][n]; s += (x[0] + x[1]) + (x[2] + x[3]); }
            s += __shfl_xor(s, 16); s += __shfl_xor(s, 32);
            const float mw = s * (1.0f / 64.0f); float q = 0.f;
#pragma unroll
            for (int bj = 0; bj < 2; ++bj)
#pragma unroll
                for (int n = 0; n < 2; ++n) { const f32x4 d = v[ai][bj][m][n] - mw; q += (d[0] * d[0] + d[1] * d[1]) + (d[2] * d[2] + d[3] * d[3]); }
            q += __shfl_xor(q, 16); q += __shfl_xor(q, 32);
            if (fq == 0) P[(ai * HALF + wr * 64 + m * 16 + fr) * 4 + wc] = (f32x2){mw, q};
            __builtin_amdgcn_sched_barrier(0);
        }
    asm volatile("s_waitcnt lgkmcnt(0)" ::: "memory"); __builtin_amdgcn_s_barrier(); asm volatile("" ::: "memory");
    const int row = wid * 32 + (lane & 31);
    if (lane < 32) {
        const f32x2 a = P[row * 4 + 0], b = P[row * 4 + 1], c = P[row * 4 + 2], d = P[row * 4 + 3];
        const float mt = (a.x + b.x + c.x + d.x) * 0.25f;
        const float da = a.x - mt, db = b.x - mt, dc = c.x - mt, dd = d.x - mt;
        const float m2 = (a.y + b.y) + (c.y + d.y) + 64.0f * ((da * da + db * db) + (dc * dc + dd * dd));
        unsigned long long* slot = xbuf + ((size_t)(pm * BM + row) * 8 + pn);
        __hip_atomic_store(slot, ((unsigned long long)__builtin_bit_cast(unsigned, m2) << 32) | __builtin_bit_cast(unsigned, mt), __ATOMIC_RELAXED, __HIP_MEMORY_SCOPE_AGENT);
    }
    asm volatile("s_waitcnt vmcnt(0)" ::: "memory");
    if (lane == 0) __hip_atomic_fetch_add(cnt + 64 * pm, 1u, __ATOMIC_RELAXED, __HIP_MEMORY_SCOPE_AGENT);
    if (wid == 0) {
        while ((unsigned)__builtin_amdgcn_readfirstlane(__hip_atomic_load(cnt + 64 * pm, __ATOMIC_RELAXED, __HIP_MEMORY_SCOPE_AGENT)) < 64u) __builtin_amdgcn_s_sleep(2);
        __builtin_amdgcn_fence(__ATOMIC_ACQUIRE, "agent");
    }
    asm volatile("s_waitcnt vmcnt(0) lgkmcnt(0)" ::: "memory"); __builtin_amdgcn_s_barrier(); asm volatile("" ::: "memory");
    if (lane < 32) {
        const unsigned long long* slot = xbuf + (size_t)(pm * BM + row) * 8; float mt[8], m2[8]; float ms = 0.f;
#pragma unroll
        for (int t = 0; t < 8; ++t) { const unsigned long long w = __hip_atomic_load(slot + t, __ATOMIC_RELAXED, __HIP_MEMORY_SCOPE_AGENT); mt[t] = __builtin_bit_cast(float, (unsigned)w); m2[t] = __builtin_bit_cast(float, (unsigned)(w >> 32)); ms += mt[t]; }
        const float mean = ms * 0.125f; float q = 0.f;
#pragma unroll
        for (int t = 0; t < 8; ++t) { const float dm = mt[t] - mean; q += m2[t] + 256.0f * dm * dm; }
        S[row] = (f32x2){mean, rsqrtf(q * (1.0f / DM) + LN_EPS)};
    }
    asm volatile("s_waitcnt lgkmcnt(0)" ::: "memory"); __builtin_amdgcn_s_barrier(); asm volatile("" ::: "memory");
}

template <int mode> struct Epi {
    unsigned char* ws; const float* pa; const float* pb; const float* pc; float* outp;
    __device__ __forceinline__ void operator()(f32x4 (&acc)[2][2][4][2], const Unit& u, int wr, int wc, int fr, int fq, LAS unsigned char* lds, int wid, int lane) const {
        const int row0 = u.pm * BM + wr * 64 + fr;
        const int cb = wc * 32 + 8 * fq;
        if constexpr (mode == E_M1) {
            bf16_t* O = (bf16_t*)(ws + WS_HID); const float* b1 = pa;
            f32x4 bv[2][2];
#pragma unroll
            for (int bj = 0; bj < 2; ++bj)
#pragma unroll
                for (int n = 0; n < 2; ++n) bv[bj][n] = *(const f32x4*)(b1 + u.pn * BM + bj * HALF + cb + 4 * n);
#pragma unroll
            for (int ai = 0; ai < 2; ++ai)
#pragma unroll
                for (int m = 0; m < 4; ++m) { bf16_t* rowp = O + (size_t)(row0 + ai * HALF + m * 16) * DFF + u.pn * BM + cb;
#pragma unroll
                    for (int bj = 0; bj < 2; ++bj) { f32x4 v0 = acc[ai][bj][m][0] + bv[bj][0], v1 = acc[ai][bj][m][1] + bv[bj][1];
#pragma unroll
                        for (int j = 0; j < 4; ++j) { const float a = fmaxf(v0[j], 0.f), b = fmaxf(v1[j], 0.f); v0[j] = a * a; v1[j] = b * b; }
                        u32x4 w; w.x = cvt_pk_bf16(v0[0], v0[1]); w.y = cvt_pk_bf16(v0[2], v0[3]); w.z = cvt_pk_bf16(v1[0], v1[1]); w.w = cvt_pk_bf16(v1[2], v1[3]);
                        *(u32x4*)(rowp + bj * HALF) = w; } }
        } else if constexpr (mode == E_M2 || mode == E_WOUT) {
            const bool m2 = (mode == E_M2);
            const float* base = m2 ? (const float*)outp : pa; float* out = outp;
            const float* mod = (const float*)(ws + WS_MOD) + (size_t)(u.pm >> 3) * 12288 + (m2 ? 10240 : 4096);
            const float* b2 = pa;
            f32x4 gv[2][2], bv[2][2];
#pragma unroll
            for (int bj = 0; bj < 2; ++bj)
#pragma unroll
                for (int n = 0; n < 2; ++n) { const int c = u.pn * BM + bj * HALF + cb + 4 * n; gv[bj][n] = *(const f32x4*)(mod + c);
                    bv[bj][n] = m2 ? *(const f32x4*)(b2 + c) : (f32x4){0.f, 0.f, 0.f, 0.f}; }
#pragma unroll
            for (int ai = 0; ai < 2; ++ai)
#pragma unroll
                for (int m = 0; m < 4; ++m) { const size_t ro = (size_t)(row0 + ai * HALF + m * 16) * DM + u.pn * BM + cb;
#pragma unroll
                    for (int bj = 0; bj < 2; ++bj)
#pragma unroll
                        for (int n = 0; n < 2; ++n) { const f32x4 xb = *(const f32x4*)(base + ro + bj * HALF + 4 * n);
                            const f32x4 v = xb * ALPHA_F + gv[bj][n] * (acc[ai][bj][m][n] + bv[bj][n]);
                            *(f32x4*)(out + ro + bj * HALF + 4 * n) = v; } }
        } else if constexpr (mode == E_WOUTF || mode == E_M2F) {
            constexpr bool m2 = (mode == E_M2F);
            const float* base = m2 ? (const float*)outp : pa; float* out = outp;
            const float* mod = (const float*)(ws + WS_MOD) + (size_t)(u.pm >> 3) * 12288;
            const float* gate = mod + (m2 ? 10240 : 4096);
            const float* lg = pb;
            const int c0 = u.pn * BM + cb;
#define MEMFENCE() do { asm volatile("" ::: "memory"); __builtin_amdgcn_sched_barrier(0); } while (0)
#define OPQ(p) asm volatile("" : "+v"(p))
#pragma unroll
            for (int bj = 0; bj < 2; ++bj)
#pragma unroll
                for (int n = 0; n < 2; ++n) { const int c = c0 + bj * HALF + 4 * n; const f32x4 gv = *(const f32x4*)(gate + c);
                    f32x4 bv = {0.f, 0.f, 0.f, 0.f}; if (m2) bv = *(const f32x4*)(pa + c);
                    const float* rp = base + (size_t)row0 * DM + c; OPQ(rp);
#pragma unroll
                    for (int ai = 0; ai < 2; ++ai) {
#pragma unroll
                        for (int m = 0; m < 4; ++m) { const f32x4 xb = *(const f32x4*)rp; rp += (m == 3 ? 80 : 16) * DM; OPQ(rp);
                            acc[ai][bj][m][n] = xb * ALPHA_F + gv * (acc[ai][bj][m][n] + bv); OPQ(acc[ai][bj][m][n]); }
                        MEMFENCE(); } }
            unsigned long long* xb0 = (unsigned long long*)(ws + WS_XBUF) + (size_t)(m2 ? 2 : 0) * MLAT * 8;
            unsigned* cn0 = (unsigned*)(ws + WS_CNT) + (size_t)(m2 ? 2 : 0) * 64 * 64;
            panel_stats(acc, u.pm, u.pn, wr, wc, fr, fq, lds, wid, lane, xb0, cn0);
            const LAS f32x2* S = (const LAS f32x2*)(lds + XL_OFF + 8192);
            const int rl0 = wr * 64 + fr;
#pragma unroll
            for (int bj = 0; bj < 2; ++bj)
#pragma unroll
                for (int n = 0; n < 2; ++n) { const int c = c0 + bj * HALF + 4 * n; const f32x4 lgv = *(const f32x4*)(lg + c), lbv = *(const f32x4*)(pc + c);
                    float* op = out + (size_t)row0 * DM + c; OPQ(op);
#pragma unroll
                    for (int ai = 0; ai < 2; ++ai) {
#pragma unroll
                        for (int m = 0; m < 4; ++m) { const f32x2 st = S[rl0 + ai * HALF + m * 16];
                            const f32x4 o = (acc[ai][bj][m][n] - st.x) * st.y * lgv + lbv;
                            acc[ai][bj][m][n] = o; *(f32x4*)op = o; op += (m == 3 ? 80 : 16) * DM; OPQ(op); }
                        MEMFENCE(); } }
            if constexpr (!m2) {
                panel_stats(acc, u.pm, u.pn, wr, wc, fr, fq, lds, wid, lane, xb0 + (size_t)MLAT * 8, cn0 + 64 * 64);
#pragma unroll
                for (int bj = 0; bj < 2; ++bj) { const int c = c0 + bj * HALF;
                    const f32x4 sc0 = *(const f32x4*)(mod + 4 * DM + c) + 1.f, sc1 = *(const f32x4*)(mod + 4 * DM + c + 4) + 1.f, sh0 = *(const f32x4*)(mod + 3 * DM + c), sh1 = *(const f32x4*)(mod + 3 * DM + c + 4);
                    bf16_t* hp = (bf16_t*)(ws + WS_H2) + (size_t)row0 * DM + c; OPQ(hp);
#pragma unroll
                    for (int ai = 0; ai < 2; ++ai) {
#pragma unroll
                        for (int m = 0; m < 4; ++m) { const f32x2 st = S[rl0 + ai * HALF + m * 16];
                            const f32x4 h0 = (acc[ai][bj][m][0] - st.x) * st.y * sc0 + sh0;
                            const f32x4 h1 = (acc[ai][bj][m][1] - st.x) * st.y * sc1 + sh1;
                            u32x4 w; w.x = cvt_pk_bf16(h0[0], h0[1]); w.y = cvt_pk_bf16(h0[2], h0[3]); w.z = cvt_pk_bf16(h1[0], h1[1]); w.w = cvt_pk_bf16(h1[2], h1[3]);
                            *(u32x4*)hp = w; hp += (m == 3 ? 80 : 16) * DM; OPQ(hp); }
                        MEMFENCE(); } }
            }
#undef OPQ
#undef MEMFENCE
        } else if constexpr (mode == E_AUP || mode == E_SUP) {
            const bool sup = (mode == E_SUP);
            bf16_t* MG = (bf16_t*)(ws + WS_MERG); const bf16_t* SG = (const bf16_t*)(ws + (sup ? WS_SGS : WS_SGA));
#pragma unroll
            for (int ai = 0; ai < 2; ++ai)
#pragma unroll
                for (int m = 0; m < 4; ++m) { const size_t ro = (size_t)(row0 + ai * HALF + m * 16) * DM + u.pn * BM + cb;
#pragma unroll
                    for (int bj = 0; bj < 2; ++bj) { const u32x4 g = *(const u32x4*)(SG + ro + bj * HALF);
                        f32x4 v0 = acc[ai][bj][m][0], v1 = acc[ai][bj][m][1];
                        v0[0] *= bflo(g.x); v0[1] *= bfhi(g.x); v0[2] *= bflo(g.y); v0[3] *= bfhi(g.y);
                        v1[0] *= bflo(g.z); v1[1] *= bfhi(g.z); v1[2] *= bflo(g.w); v1[3] *= bfhi(g.w);
                        if (sup) { const u32x4 o = *(const u32x4*)(MG + ro + bj * HALF);
                            v0[0] += bflo(o.x); v0[1] += bfhi(o.x); v0[2] += bflo(o.y); v0[3] += bfhi(o.y);
                            v1[0] += bflo(o.z); v1[1] += bfhi(o.z); v1[2] += bflo(o.w); v1[3] += bfhi(o.w); }
                        u32x4 w; w.x = cvt_pk_bf16(v0[0], v0[1]); w.y = cvt_pk_bf16(v0[2], v0[3]); w.z = cvt_pk_bf16(v1[0], v1[1]); w.w = cvt_pk_bf16(v1[2], v1[3]);
                        *(u32x4*)(MG + ro + bj * HALF) = w; } }
        } else if constexpr (mode == E_GLU) {
            bf16_t* O = (bf16_t*)(ws + WS_SGLU);
#pragma unroll
            for (int ai = 0; ai < 2; ++ai)
#pragma unroll
                for (int m = 0; m < 4; ++m) { bf16_t* rowp = O + (size_t)(row0 + ai * HALF + m * 16) * SW + u.pn * HALF + cb;
                    f32x4 v0, v1;
#pragma unroll
                    for (int j = 0; j < 4; ++j) { v0[j] = acc[ai][0][m][0][j] * sigmoidf_(acc[ai][1][m][0][j]); v1[j] = acc[ai][0][m][1][j] * sigmoidf_(acc[ai][1][m][1][j]); }
                    u32x4 w; w.x = cvt_pk_bf16(v0[0], v0[1]); w.y = cvt_pk_bf16(v0[2], v0[3]); w.z = cvt_pk_bf16(v1[0], v1[1]); w.w = cvt_pk_bf16(v1[2], v1[3]);
                    *(u32x4*)rowp = w; }
        } else if constexpr (mode == E_S5A) {
            float* O = (float*)(ws + WS_SLOC); const int g = u.pn, rg0 = (u.pm - 5 * g) * BM + wr * 64 + fr;
#pragma unroll
            for (int ai = 0; ai < 2; ++ai)
#pragma unroll
                for (int m = 0; m < 4; ++m) { float* rowp = O + ((size_t)g * S5ROWS + rg0 + ai * HALF + m * 16) * 256 + cb;
#pragma unroll
                    for (int bj = 0; bj < 2; ++bj)
#pragma unroll
                        for (int n = 0; n < 2; ++n) *(f32x4*)(rowp + bj * HALF + 4 * n) = acc[ai][bj][m][n]; }
        } else if constexpr (mode == E_S5C) {
            bf16_t* O = (bf16_t*)(ws + WS_SACT); const int g = u.pn, rg0 = (u.pm - 5 * g) * BM + wr * 64 + fr;
#pragma unroll
            for (int ai = 0; ai < 2; ++ai)
#pragma unroll
                for (int m = 0; m < 4; ++m) { const int rg = rg0 + ai * HALF + m * 16, b = rg >> 7, ch = rg & 127;
#pragma unroll
                    for (int bj = 0; bj < 2; ++bj) { const int t = 8 * bj + 2 * wc + (fq >> 1); const int token = b * SEQ + ch * 16 + t;
                        const f32x4 v0 = acc[ai][bj][m][0], v1 = acc[ai][bj][m][1];
                        u32x4 w; w.x = cvt_pk_bf16(gelu_tanh(v0[0]), gelu_tanh(v0[1])); w.y = cvt_pk_bf16(gelu_tanh(v0[2]), gelu_tanh(v0[3]));
                        w.z = cvt_pk_bf16(gelu_tanh(v1[0]), gelu_tanh(v1[1])); w.w = cvt_pk_bf16(gelu_tanh(v1[2]), gelu_tanh(v1[3]));
                        *(u32x4*)(O + (size_t)token * SW + g * 16 + 8 * (fq & 1)) = w; } }
        } else {
            const int pn = u.pn;
            if (pn <= 4) {
                const bool isq = pn < 4, lat = u.pm < 64;
                const float* rope = (const float*)(ws + WS_ROPE);
                const int f0 = 16 * (wc & 1) + 4 * fq;
#pragma unroll
                for (int ai = 0; ai < 2; ++ai)
#pragma unroll
                    for (int m = 0; m < 4; ++m) { const int r = row0 + ai * HALF + m * 16;
                        f32x4 c0 = {1.f, 0.f, 1.f, 0.f}, c1 = {1.f, 0.f, 1.f, 0.f};
                        size_t orow;
                        if (lat) { const int l = r & (SEQ - 1); const int posv = (wc < 2) ? (l >> 6) : (l & 63);
                            const float* rp = rope + (size_t)(posv * 32 + f0) * 2; c0 = *(const f32x4*)rp; c1 = *(const f32x4*)(rp + 4);
                            orow = isq ? (size_t)r : (size_t)((r >> 11) * KROWS + l); }
                        else { const int rc = r - MLAT; orow = (size_t)((rc >> 8) * KROWS + SEQ + (rc & 255)); }
                        const float sc = isq ? QSCALE : 1.f;
#pragma unroll
                        for (int bj = 0; bj < 2; ++bj) { const f32x4 a0 = acc[ai][bj][m][0], a1 = acc[ai][bj][m][1];
                            const float o0 = (a0[0] * c0[0] - a0[1] * c0[1]) * sc, o1 = (a0[1] * c0[0] + a0[0] * c0[1]) * sc;
                            const float o2 = (a0[2] * c0[2] - a0[3] * c0[3]) * sc, o3 = (a0[3] * c0[2] + a0[2] * c0[3]) * sc;
                            const float o4 = (a1[0] * c1[0] - a1[1] * c1[1]) * sc, o5 = (a1[1] * c1[0] + a1[0] * c1[1]) * sc;
                            const float o6 = (a1[2] * c1[2] - a1[3] * c1[3]) * sc, o7 = (a1[3] * c1[2] + a1[2] * c1[3]) * sc;
                            u32x4 w; w.x = cvt_pk_bf16(o0, o1); w.y = cvt_pk_bf16(o2, o3); w.z = cvt_pk_bf16(o4, o5); w.w = cvt_pk_bf16(o6, o7);
                            bf16_t* dst = isq ? (bf16_t*)(ws + WS_QB) + orow * QW + pn * BM + bj * HALF + cb
                                              : (bf16_t*)(ws + WS_KB) + orow * 256 + bj * HALF + cb;
                            *(u32x4*)dst = w; } }
            } else if (pn == 5) {
                bf16_t* VT = (bf16_t*)(ws + WS_VT);
#pragma unroll
                for (int ai = 0; ai < 2; ++ai)
#pragma unroll
                    for (int m = 0; m < 4; ++m) { const int r = row0 + ai * HALF + m * 16; int b, key;
                        if (u.pm < 64) { b = r >> 11; key = r & (SEQ - 1); } else { const int rc = r - MLAT; b = rc >> 8; key = SEQ + (rc & 255); }
#pragma unroll
                        for (int bj = 0; bj < 2; ++bj) { bf16_t* dst = VT + ((size_t)(b * 2 + bj) * HD + cb) * KROWS + key;
#pragma unroll
                            for (int n = 0; n < 2; ++n)
#pragma unroll
                                for (int j = 0; j < 4; ++j) dst[(size_t)(4 * n + j) * KROWS] = (bf16_t)f2bf(acc[ai][bj][m][n][j]); } }
            } else if (pn <= 7) {
                bf16_t* U = (bf16_t*)(ws + WS_U);
#pragma unroll
                for (int ai = 0; ai < 2; ++ai)
#pragma unroll
                    for (int m = 0; m < 4; ++m) { const int r = row0 + ai * HALF + m * 16; int urow, t;
                        if (u.pm < 64) { const int l = r & (SEQ - 1); urow = (r >> 11) * 128 + (l >> 4); t = l & 15; }
                        else { const int rc = r - MLAT; urow = 1024 + (rc >> 8) * 16 + ((rc & 255) >> 4); t = rc & 15; }
#pragma unroll
                        for (int bj = 0; bj < 2; ++bj) { const int g = (pn - 6) * 16 + 8 * bj + 2 * wc + (fq >> 1);
                            const f32x4 v0 = acc[ai][bj][m][0], v1 = acc[ai][bj][m][1];
                            u32x4 w; w.x = cvt_pk_bf16(v0[0], v0[1]); w.y = cvt_pk_bf16(v0[2], v0[3]); w.z = cvt_pk_bf16(v1[0], v1[1]); w.w = cvt_pk_bf16(v1[2], v1[3]);
                            *(u32x4*)(U + ((size_t)g * S5ROWS + urow) * 512 + t * 16 + 8 * (fq & 1)) = w; } }
            } else {
                const bool isa = pn < 16; bf16_t* SG = (bf16_t*)(ws + (isa ? WS_SGA : WS_SGS)); const int ct = (pn - (isa ? 8 : 16)) * BM + cb;
#pragma unroll
                for (int ai = 0; ai < 2; ++ai)
#pragma unroll
                    for (int m = 0; m < 4; ++m) { bf16_t* rowp = SG + (size_t)(row0 + ai * HALF + m * 16) * DM + ct;
#pragma unroll
                        for (int bj = 0; bj < 2; ++bj) { const f32x4 v0 = acc[ai][bj][m][0], v1 = acc[ai][bj][m][1];
                            u32x4 w; w.x = cvt_pk_bf16(sigmoidf_(v0[0]), sigmoidf_(v0[1])); w.y = cvt_pk_bf16(sigmoidf_(v0[2]), sigmoidf_(v0[3]));
                            w.z = cvt_pk_bf16(sigmoidf_(v1[0]), sigmoidf_(v1[1])); w.w = cvt_pk_bf16(sigmoidf_(v1[2]), sigmoidf_(v1[3]));
                            *(u32x4*)(rowp + bj * HALF) = w; } }
            }
        }
    }
};

template <int MODE> __device__ __forceinline__ void gemm_phase(LAS unsigned char* lds, const Gemm g, const Order& S, const Epi<MODE>& E, int tid) {
    const int wid = __builtin_amdgcn_readfirstlane(tid >> 6), lane = tid & 63, wr = wid >> 2, wc = wid & 3, fr = lane & 15, fq = lane >> 4;
    const int K = g.K, nt = K / BK;
    unsigned voffA[2], voffB[2];
#pragma unroll
    for (int i = 0; i < 2; ++i) { int R, C; stage_rc(tid * 16 + i * 8192, R, C); const int Rb = (R & ~31) + perm32(R & 31);
        voffA[i] = (unsigned)(R * g.lda + C) * 2u; voffB[i] = (unsigned)(Rb * g.ldb + C) * 2u; }
    const size_t kstep = (size_t)(BK * 2);
    const size_t hstepA = (size_t)HALF * g.lda * 2, hstepB = (size_t)HALF * g.ldb * 2;
    const size_t tstepA = 2 * hstepA, tstepB = 2 * hstepB;
    const unsigned ldsw = (unsigned)wid * 1024u;
    const int aoff = lds_byte(wr * 64 + fr, fq * 8), boff = lds_byte(wc * 32 + fr, fq * 8);
#define PG8_SA(b, h) (((b) * 2 + (h)) * HTB)
#define PG8_SB(b, h) ((4 + (b) * 2 + (h)) * HTB)
#define PG8_STAGE(bufoff, gbase, voff) do { _Pragma("unroll") for (int _i = 0; _i < 2; ++_i) \
        __builtin_amdgcn_global_load_lds((const unsigned*)((const char*)(gbase) + (voff)[_i]), (LAS unsigned*)(lds + (bufoff) + ldsw + _i * 8192), 16, 0, 0); } while (0)
#define PG8_LDA(dst, b, h) do { _Pragma("unroll") for (int m = 0; m < 4; ++m) _Pragma("unroll") for (int k = 0; k < 2; ++k) dst[m][k] = *(const LAS bf16x8*)(lds + PG8_SA(b, h) + aoff + m * 2048 + k * 1024); } while (0)
#define PG8_LDB(dst, b, h) do { _Pragma("unroll") for (int n = 0; n < 2; ++n) _Pragma("unroll") for (int k = 0; k < 2; ++k) dst[n][k] = *(const LAS bf16x8*)(lds + PG8_SB(b, h) + boff + n * 2048 + k * 1024); } while (0)
#define PG8_MMA(ai, bj, At, Bt) do { __builtin_amdgcn_s_setprio(1); _Pragma("unroll") for (int m = 0; m < 4; ++m) _Pragma("unroll") for (int n = 0; n < 2; ++n) _Pragma("unroll") for (int k = 0; k < 2; ++k) \
        acc[ai][bj][m][n] = __builtin_amdgcn_mfma_f32_16x16x32_bf16(Bt[n][k], At[m][k], acc[ai][bj][m][n], 0, 0, 0); __builtin_amdgcn_s_setprio(0); } while (0)
#define PG8_WAIT_V(n) asm volatile("s_waitcnt vmcnt(" #n ")" ::: "memory")
#define PG8_WAIT_L(n) asm volatile("s_waitcnt lgkmcnt(" #n ")" ::: "memory")
#define PG8_BAR __builtin_amdgcn_s_barrier()
#define PG8_SCHED __builtin_amdgcn_sched_barrier(0)
    Unit cur, nxt; int ui = 0;
    if (!S.next(0, cur)) return;
    f32x4 acc[2][2][4][2];
#pragma unroll
    for (int a = 0; a < 2; ++a)
#pragma unroll
        for (int b = 0; b < 2; ++b)
#pragma unroll
            for (int m = 0; m < 4; ++m)
#pragma unroll
                for (int n = 0; n < 2; ++n) acc[a][b][m][n] = (f32x4){0.f, 0.f, 0.f, 0.f};
    bf16x8 At[4][2], B0[2][2], B1[2][2];
    const char* cA = (const char*)g.A + (size_t)cur.pm * tstepA; const char* cB = (const char*)g.Bt + (size_t)cur.pn * tstepB;
    PG8_STAGE(PG8_SB(0, 0), cB, voffB); PG8_STAGE(PG8_SB(0, 1), cB + hstepB, voffB); PG8_STAGE(PG8_SA(0, 0), cA, voffA); PG8_STAGE(PG8_SA(0, 1), cA + hstepA, voffA);
    if (wr == 1) PG8_BAR;
    PG8_WAIT_V(2); PG8_BAR;
    PG8_STAGE(PG8_SB(1, 0), cB + kstep, voffB); PG8_STAGE(PG8_SA(1, 0), cA + kstep, voffA); PG8_STAGE(PG8_SB(1, 1), cB + hstepB + kstep, voffB);
    PG8_WAIT_V(6); PG8_BAR;
    for (;;) {
        const bool has_next = S.next(ui + 1, nxt);
        const char* nA = has_next ? (const char*)g.A + (size_t)nxt.pm * tstepA : cA; const char* nB = has_next ? (const char*)g.Bt + (size_t)nxt.pn * tstepB : cB;
        for (int t = 0; t < nt; t += 2) {
            const bool last = (t == nt - 2);
            const char* a1 = cA + (size_t)(t + 1) * kstep;
            const char* a2 = last ? nA : cA + (size_t)(t + 2) * kstep; const char* b2 = last ? nB : cB + (size_t)(t + 2) * kstep;
            const char* a3 = a2 + kstep; const char* b3 = b2 + kstep;
            PG8_LDB(B0, 0, 0); PG8_LDB(B1, 0, 1); PG8_SCHED; PG8_LDA(At, 0, 0); PG8_STAGE(PG8_SA(1, 1), a1 + hstepA, voffA);
            PG8_WAIT_V(8); PG8_WAIT_L(0); PG8_BAR; PG8_MMA(0, 0, At, B0); PG8_MMA(0, 1, At, B1); PG8_BAR; PG8_SCHED;
            PG8_LDA(At, 0, 1); PG8_STAGE(PG8_SB(0, 0), b2, voffB); PG8_STAGE(PG8_SB(0, 1), b2 + hstepB, voffB); PG8_STAGE(PG8_SA(0, 0), a2, voffA);
            PG8_WAIT_V(8); PG8_WAIT_L(0); PG8_BAR; PG8_MMA(1, 0, At, B0); PG8_MMA(1, 1, At, B1); PG8_BAR; PG8_SCHED;
            PG8_LDB(B0, 1, 0); PG8_LDB(B1, 1, 1); PG8_SCHED; PG8_LDA(At, 1, 0); PG8_STAGE(PG8_SA(0, 1), a2 + hstepA, voffA);
            PG8_WAIT_V(8); PG8_WAIT_L(0); PG8_BAR; PG8_MMA(0, 0, At, B0); PG8_MMA(0, 1, At, B1); PG8_BAR; PG8_SCHED;
            PG8_LDA(At, 1, 1); PG8_STAGE(PG8_SB(1, 0), b3, voffB); PG8_STAGE(PG8_SB(1, 1), b3 + hstepB, voffB); PG8_STAGE(PG8_SA(1, 0), a3, voffA);
            PG8_WAIT_V(8); PG8_WAIT_L(0); PG8_BAR; PG8_MMA(1, 0, At, B0); PG8_MMA(1, 1, At, B1); PG8_BAR; PG8_SCHED;
        }
        if (wr == 0) PG8_BAR;
        { const int l2 = lane_id(); E(acc, cur, wr, wc, l2 & 15, l2 >> 4, lds, wid, l2); }
        if (!has_next) break;
#pragma unroll
        for (int a = 0; a < 2; ++a)
#pragma unroll
            for (int b = 0; b < 2; ++b)
#pragma unroll
                for (int m = 0; m < 4; ++m)
#pragma unroll
                    for (int n = 0; n < 2; ++n) acc[a][b][m][n] = (f32x4){0.f, 0.f, 0.f, 0.f};
        cur = nxt; cA = nA; cB = nB; ++ui;
        if (wr == 1) PG8_BAR;
    }
    PG8_WAIT_V(0);
    PG8_BAR;
#undef PG8_SA
#undef PG8_SB
#undef PG8_STAGE
#undef PG8_LDA
#undef PG8_LDB
#undef PG8_MMA
#undef PG8_WAIT_V
#undef PG8_WAIT_L
#undef PG8_BAR
#undef PG8_SCHED
}

__device__ __forceinline__ int src_col(int mode, int n) {
    if (mode == 1) { if (n >= 1280) return n; const int pos = n & 127, mm = pos >> 1, sec = pos & 1; const int i = mm + ((mm >= 32) ? 32 : 0); return (n & ~127) + i + 32 * sec; }
    if (mode == 2) { const int t = n >> 8, w = n & 255; return (w < 128) ? t * 128 + w : 512 + t * 128 + (w - 128); }
    return n;
}
__device__ __forceinline__ void p0_transpose_item(const float* W, int K, int N, bf16_t* WT, int mode, LAS float* scr, int item, int lane) {
    const int nblk = N / 32, kb = item / nblk, nb = item % nblk, k0 = 64 * kb, n0 = 32 * nb;
    const int sc = src_col(mode, n0 + (lane & 31));
#pragma unroll 8
    for (int i = 0; i < 32; ++i) { const int kk = 2 * i + (lane >> 5); scr[kk * 33 + (lane & 31)] = W[(size_t)(k0 + kk) * N + sc]; }
    LDS_WAIT(); asm volatile("" ::: "memory");
    const int c = lane & 7;
#pragma unroll
    for (int j = 0; j < 4; ++j) { const int n = (lane >> 3) + 8 * j; const LAS float* s = scr + (8 * c) * 33 + n;
        u32x4 o; o.x = pk2(s[0 * 33], s[1 * 33]); o.y = pk2(s[2 * 33], s[3 * 33]); o.z = pk2(s[4 * 33], s[5 * 33]); o.w = pk2(s[6 * 33], s[7 * 33]);
        *(u32x4*)(WT + (size_t)(n0 + n) * K + k0 + 8 * c) = o; }
    LDS_WAIT(); asm volatile("" ::: "memory");
}

__device__ __forceinline__ void ada_item(LAS unsigned char* lds, int item, int tid) {
    LAS float* scv = (LAS float*)lds;
    LAS float* red = (LAS float*)(lds + 73728);
    for (int i = tid; i < 9 * DM; i += 512) { const float v = (i < 8 * DM) ? KP->in[1][i] : KP->in[3][i - 8 * DM]; scv[i] = v / (1.f + __expf(-v)); }
    __syncthreads();
    const int cl = tid & 15, kg = tid >> 4, n0 = item * 64;
    const float* w = KP->in[4] + (size_t)(kg * 64) * 12288 + n0 + 4 * cl;
    f32x4 a[9];
#pragma unroll
    for (int m = 0; m < 9; ++m) a[m] = (f32x4){0.f, 0.f, 0.f, 0.f};
#pragma unroll 4
    for (int k = 0; k < 64; ++k) { const f32x4 wv = *(const f32x4*)(w + (size_t)k * 12288);
#pragma unroll
        for (int m = 0; m < 9; ++m) a[m] += wv * scv[m * DM + kg * 64 + k]; }
#pragma unroll
    for (int m = 0; m < 9; ++m) *(LAS f32x4*)(red + (kg * 9 + m) * 64 + 4 * cl) = a[m];
    __syncthreads();
    float* MOD = (float*)(KP->ws + WS_MOD);
    for (int i = tid; i < 9 * 64; i += 512) { const int m = i >> 6, col = i & 63; float s = KP->in[5][n0 + col];
        for (int q = 0; q < 32; ++q) s += red[(q * 9 + m) * 64 + col];
        MOD[(size_t)m * 12288 + n0 + col] = s; }
    __syncthreads();
}

__device__ __forceinline__ void s5_precompute(LAS unsigned char* lds, int g, int tid) {
    LAS float* Ere = (LAS float*)lds;
    LAS float* Eim = Ere + 2176;
    LAS float* Bre = Eim + 2176;
    LAS float* Bim = Bre + 2048;
    LAS float* Cre = Bim + 2048;
    LAS float* Cim = Cre + 2048;
    LAS float* Cf = Cim + 2048;
    float* LAMT = (float*)(KP->ws + WS_LAMT);
    if (tid < 128) {
        const int dir = tid >> 6, pp = tid & 63;
        const float are = KP->in[8][(dir * 32 + g) * 64 + pp], aim = KP->in[9][(dir * 32 + g) * 64 + pp];
        const float dt = expf(KP->in[10][dir * 32 + g]);
        const float mag = expf(are * dt); float sn, cs; sincosf(aim * dt, &sn, &cs);
        const float lr = mag * cs, li = mag * sn;
        const float nr = lr - 1.f, ni = li, den = are * are + aim * aim;
        Cf[tid * 2] = (nr * are + ni * aim) / den; Cf[tid * 2 + 1] = (ni * are - nr * aim) / den;
        float er = 1.f, ei = 0.f;
        for (int d = 0; d <= 16; ++d) { Ere[tid * 17 + d] = er; Eim[tid * 17 + d] = ei;
            if (d == 16) { LAMT[((g * 2 + dir) * 2 + 0) * 64 + pp] = er; LAMT[((g * 2 + dir) * 2 + 1) * 64 + pp] = ei; }
            const float t = er * lr - ei * li; ei = er * li + ei * lr; er = t; }
    }
    __syncthreads();
    for (int idx = tid; idx < 2048; idx += 512) { const int dir = idx >> 10, pp = (idx >> 4) & 63, h = idx & 15;
        const size_t si = ((size_t)(dir * 32 + g) * 64 + pp) * 16 + h; const float br = KP->in[11][si], bi = KP->in[12][si];
        const float cr = Cf[(dir * 64 + pp) * 2], ci = Cf[(dir * 64 + pp) * 2 + 1];
        Bre[idx] = cr * br - ci * bi; Bim[idx] = cr * bi + ci * br;
        const int hh = (idx >> 6) & 15, p2 = idx & 63; const size_t ci2 = ((size_t)(dir * 32 + g) * 16 + hh) * 64 + p2;
        Cre[idx] = KP->in[13][ci2]; Cim[idx] = KP->in[14][ci2]; }
    __syncthreads();
    bf16_t* Wm = (bf16_t*)(KP->ws + WS_WMAT) + (size_t)g * 256 * 256;
    bf16_t* Mm = (bf16_t*)(KP->ws + WS_MMAT) + (size_t)g * 256 * 512;
    for (int idx = tid; idx < 65536; idx += 512) {
        {
            const int n = idx >> 8, k = idx & 255, dir = n >> 7, ri = (n >> 6) & 1, pp = n & 63, j = k >> 4, hh = k & 15, e = dir ? j : 15 - j;
            const float er = Ere[(dir * 64 + pp) * 17 + e], ei = Eim[(dir * 64 + pp) * 17 + e], br = Bre[(dir * 64 + pp) * 16 + hh], bi = Bim[(dir * 64 + pp) * 16 + hh];
            Wm[idx] = (bf16_t)f2bf(ri ? (er * bi + ei * br) : (er * br - ei * bi));
        }
        {
            const int row = idx >> 8, t = row >> 4, hh = row & 15, cc = idx & 255, dir = cc >> 7, ri = (cc >> 6) & 1, pp = cc & 63, e = dir ? 16 - t : t + 1;
            const float er = Ere[(dir * 64 + pp) * 17 + e], ei = Eim[(dir * 64 + pp) * 17 + e], cr = Cre[(dir * 16 + hh) * 64 + pp], ci = Cim[(dir * 16 + hh) * 64 + pp];
            Mm[(size_t)row * 512 + 256 + cc] = (bf16_t)f2bf(ri ? -(cr * ei + ci * er) : (cr * er - ci * ei));
        }
    }
    if (tid < 496) {
        const int dd = tid / 16 - 15, hh = tid & 15, e = dd < 0 ? -dd : dd;
        float kv[16];
#pragma unroll
        for (int q = 0; q < 16; ++q) kv[q] = 0.f;
#pragma unroll
        for (int dir = 0; dir < 2; ++dir) {
            const bool on = dir == 0 ? (dd >= 0) : (dd <= 0);
            if (on) {
                for (int pp = 0; pp < 64; ++pp) {
                    const float er = Ere[(dir * 64 + pp) * 17 + e], ei = Eim[(dir * 64 + pp) * 17 + e], cr = Cre[(dir * 16 + hh) * 64 + pp], ci = Cim[(dir * 16 + hh) * 64 + pp];
                    const float gr = cr * er - ci * ei, gi = cr * ei + ci * er;
#pragma unroll
                    for (int q = 0; q < 16; ++q) kv[q] += gr * Bre[(dir * 64 + pp) * 16 + q] - gi * Bim[(dir * 64 + pp) * 16 + q];
                }
            }
        }
        if (dd == 0) { const float dv = KP->in[15][g * 16 + hh];
#pragma unroll
            for (int q = 0; q < 16; ++q) kv[q] += (q == hh) ? dv : 0.f; }
        u32x4 w0, w1;
        w0.x = pk2(kv[0], kv[1]); w0.y = pk2(kv[2], kv[3]); w0.z = pk2(kv[4], kv[5]); w0.w = pk2(kv[6], kv[7]);
        w1.x = pk2(kv[8], kv[9]); w1.y = pk2(kv[10], kv[11]); w1.z = pk2(kv[12], kv[13]); w1.w = pk2(kv[14], kv[15]);
        for (int t = 0; t < 16; ++t) { const int j = t - dd; if (j >= 0 && j < 16) { bf16_t* dst = Mm + (size_t)(t * 16 + hh) * 512 + j * 16; *(u32x4*)dst = w0; *(u32x4*)(dst + 8) = w1; } }
    }
    __syncthreads();
}

__device__ __forceinline__ void step_prologue(LAS unsigned char* lds, int tid) {
    const int lane = tid & 63, wave = tid >> 6;
    for (int it = blockIdx.x; it < 225; it += gridDim.x) {
        if (it < 32) s5_precompute(lds, it, tid);
        else if (it < 224) ada_item(lds, it - 32, tid);
        else { float* rope = (float*)(KP->ws + WS_ROPE);
            for (int idx = tid; idx < 2048; idx += 512) { const int pos = idx >> 5, f = idx & 31; const float fr_ = powf(10000.f, -(float)f / 32.f); const float ang = (float)pos * fr_;
                rope[idx * 2] = cosf(ang); rope[idx * 2 + 1] = sinf(ang); } }
    }
    __syncthreads();
}
__device__ __forceinline__ void convert_weights(LAS unsigned char* lds, int tid, bool early, bool late, int gw, int NGW) {
    const int lane = tid & 63, wave = tid >> 6;
    LAS float* scr = (LAS float*)(lds + wave * 16384);
    constexpr int I_IN = 32 * 192, I_GLU = 8 * 32, I_AUP = 16 * 64, I_SUP = 8 * 64, I_OUT = 32 * 64, I_M1 = 32 * 256, I_M2 = 128 * 64;
    constexpr int N_EARLY = I_IN + I_GLU, NITEMS = N_EARLY + I_AUP + I_SUP + I_OUT + I_M1 + I_M2;
    unsigned char* ws = KP->ws;
    const int it0 = early ? 0 : N_EARLY, it1 = late ? NITEMS : N_EARLY;
    for (int it = it0 + gw; it < it1; it += NGW) {
        int r = it;
        if (r < I_IN) { p0_transpose_item(KP->in[6], DM, INC, (bf16_t*)(ws + WS_WTIN), 1, scr, r, lane); continue; } r -= I_IN;
        if (r < I_GLU) { p0_transpose_item(KP->in[16], SW, 2 * SW, (bf16_t*)(ws + WS_WTGLU), 2, scr, r, lane); continue; } r -= I_GLU;
        if (r < I_AUP) { p0_transpose_item(KP->in[17], QW, DM, (bf16_t*)(ws + WS_WTAUP), 0, scr, r, lane); continue; } r -= I_AUP;
        if (r < I_SUP) { p0_transpose_item(KP->in[18], SW, DM, (bf16_t*)(ws + WS_WTSUP), 0, scr, r, lane); continue; } r -= I_SUP;
        if (r < I_OUT) { p0_transpose_item(KP->in[19], DM, DM, (bf16_t*)(ws + WS_WTOUT), 0, scr, r, lane); continue; } r -= I_OUT;
        if (r < I_M1) { p0_transpose_item(KP->in[22], DM, DFF, (bf16_t*)(ws + WS_WTM1), 0, scr, r, lane); continue; } r -= I_M1;
        p0_transpose_item(KP->in[24], DFF, DM, (bf16_t*)(ws + WS_WTM2), 0, scr, r, lane);
    }
}

__device__ __forceinline__ void ln_stats(const f32x4 (&v)[8], float& mean, float& rstd) {
    float s = 0.f;
#pragma unroll
    for (int j = 0; j < 8; ++j) s += (v[j][0] + v[j][1]) + (v[j][2] + v[j][3]);
    mean = wave_sum(s) * (1.f / DM); float q = 0.f;
#pragma unroll
    for (int j = 0; j < 8; ++j) { const f32x4 d = v[j] - mean; q += (d[0] * d[0] + d[1] * d[1]) + (d[2] * d[2] + d[3] * d[3]); }
    rstd = rsqrtf(wave_sum(q) * (1.f / DM) + LN_EPS);
}
__device__ __forceinline__ void step_ln1(int tid) {
    const int lane = tid & 63, gw = blockIdx.x * 8 + (tid >> 6), NGW = gridDim.x * 8;
    const float* MOD = (const float*)(KP->ws + WS_MOD); bf16_t* H = (bf16_t*)(KP->ws + WS_HALL);
    for (int r = gw; r < MALL; r += NGW) {
        const float* src = (r < MLAT) ? KP->in[0] + (size_t)r * DM : KP->in[2] + (size_t)(r - MLAT) * DM;
        const float* md = MOD + (size_t)((r < MLAT) ? (r >> 11) : 8) * 12288;
        f32x4 v[8];
#pragma unroll
        for (int j = 0; j < 8; ++j) v[j] = *(const f32x4*)(src + 4 * (lane + 64 * j));
        float mean, rstd; ln_stats(v, mean, rstd);
#pragma unroll
        for (int j = 0; j < 8; ++j) { const int c = 4 * (lane + 64 * j); const f32x4 sh = *(const f32x4*)(md + c), sc = *(const f32x4*)(md + DM + c);
            const f32x4 o = (v[j] - mean) * rstd * (sc + 1.f) + sh;
            u32x2 w; w.x = cvt_pk_bf16(o[0], o[1]); w.y = cvt_pk_bf16(o[2], o[3]); *(u32x2*)(H + (size_t)r * DM + c) = w; }
    }
}
__device__ __forceinline__ void step_ln2(int tid) {
    const int lane = tid & 63, gw = blockIdx.x * 8 + (tid >> 6), NGW = gridDim.x * 8;
    const float* MOD = (const float*)(KP->ws + WS_MOD); bf16_t* H = (bf16_t*)(KP->ws + WS_H2);
    const float* lg = KP->in[20]; const float* lb = KP->in[21];
    for (int r = gw; r < MLAT; r += NGW) {
        float* row = KP->out + (size_t)r * DM; const float* md = MOD + (size_t)(r >> 11) * 12288;
        f32x4 v[8];
#pragma unroll
        for (int j = 0; j < 8; ++j) v[j] = *(const f32x4*)(row + 4 * (lane + 64 * j));
        float mean, rstd; ln_stats(v, mean, rstd);
#pragma unroll
        for (int j = 0; j < 8; ++j) { const int c = 4 * (lane + 64 * j); v[j] = (v[j] - mean) * rstd * *(const f32x4*)(lg + c) + *(const f32x4*)(lb + c); *(f32x4*)(row + c) = v[j]; }
        ln_stats(v, mean, rstd);
#pragma unroll
        for (int j = 0; j < 8; ++j) { const int c = 4 * (lane + 64 * j); const f32x4 sh = *(const f32x4*)(md + 3 * DM + c), sc = *(const f32x4*)(md + 4 * DM + c);
            const f32x4 o = (v[j] - mean) * rstd * (sc + 1.f) + sh;
            u32x2 w; w.x = cvt_pk_bf16(o[0], o[1]); w.y = cvt_pk_bf16(o[2], o[3]); *(u32x2*)(H + (size_t)r * DM + c) = w; }
    }
}
__device__ __forceinline__ void step_ln3(int tid) {
    const int lane = tid & 63, gw = blockIdx.x * 8 + (tid >> 6), NGW = gridDim.x * 8;
    const float* lg = KP->in[26]; const float* lb = KP->in[27];
    for (int r = gw; r < MLAT; r += NGW) {
        float* row = KP->out + (size_t)r * DM;
        f32x4 v[8];
#pragma unroll
        for (int j = 0; j < 8; ++j) v[j] = *(const f32x4*)(row + 4 * (lane + 64 * j));
        float mean, rstd; ln_stats(v, mean, rstd);
#pragma unroll
        for (int j = 0; j < 8; ++j) { const int c = 4 * (lane + 64 * j); *(f32x4*)(row + c) = (v[j] - mean) * rstd * *(const f32x4*)(lg + c) + *(const f32x4*)(lb + c); }
    }
}

constexpr int KS_PITCH = 272, VT_PITCH = 144, VT_OFF = 64 * KS_PITCH;
__device__ __forceinline__ void step_attn(LAS unsigned char* lds, int tid, int item0, int nitem, int istride) {
    const int w = tid >> 6, lane = tid & 63, fr = lane & 15, fq = lane >> 4;
    const bf16_t* Qb = (const bf16_t*)(KP->ws + WS_QB); const bf16_t* Kb = (const bf16_t*)(KP->ws + WS_KB); const bf16_t* Vtg = (const bf16_t*)(KP->ws + WS_VT);
    bf16_t* AO = (bf16_t*)(KP->ws + WS_ATTN);
    for (int it_ = 0; it_ < nitem; ++it_) {
        const int item = item0 + it_ * istride;
        const int hp = item & 1, n = (item >> 1) & 15, kvh = (item >> 5) & 1, b = item >> 6;
        const int head = kvh * 4 + hp * 2 + (w >> 2);
        const int q0 = n * 128 + (w & 3) * 32;
        bf16x8 qf[2][4];
#pragma unroll
        for (int qb = 0; qb < 2; ++qb)
#pragma unroll
            for (int ks = 0; ks < 4; ++ks) qf[qb][ks] = *(const bf16x8*)(Qb + (size_t)(b * SEQ + q0 + 16 * qb + fr) * QW + head * HD + 32 * ks + 8 * fq);
        const float sk = KP->in[7][head] * LOG2E;
        float m_[2] = {sk, sk}, l_[2]; l_[0] = l_[1] = (fq == 0) ? 1.f : 0.f;
        f32x4 o[2][8];
#pragma unroll
        for (int qb = 0; qb < 2; ++qb)
#pragma unroll
            for (int db = 0; db < 8; ++db) o[qb][db] = (f32x4){0.f, 0.f, 0.f, 0.f};
        const int tb_lo = (n == 0) ? 2 : 0, tb_hi = (n == 15) ? 4 : 6, nbt = tb_hi - tb_lo, ntile = nbt + 4;
        const bf16_t* kbase = Kb + (size_t)b * KROWS * 256 + kvh * HD;
        const bf16_t* vbase = Vtg + (size_t)(b * 2 + kvh) * HD * KROWS;
        u32x4 kr[2], vr[2];
        {   const int krow0 = 128 * (n - 1) + 64 * tb_lo;
#pragma unroll
            for (int i = 0; i < 2; ++i) { const int c = tid + 512 * i; kr[i] = *(const u32x4*)(kbase + (size_t)(krow0 + (c >> 4)) * 256 + (c & 15) * 8);
                vr[i] = *(const u32x4*)(vbase + (size_t)(c >> 3) * KROWS + krow0 + (c & 7) * 8); } }
        for (int t = 0; t < ntile; ++t) {
            __syncthreads();
#pragma unroll
            for (int i = 0; i < 2; ++i) { const int c = tid + 512 * i; *(LAS u32x4*)(lds + (c >> 4) * KS_PITCH + (c & 15) * 16) = kr[i];
                *(LAS u32x4*)(lds + VT_OFF + (c >> 3) * VT_PITCH + (c & 7) * 16) = vr[i]; }
            __syncthreads();
            const bool band = t < nbt;
            const int kp0 = band ? 128 * (n - 1) + 64 * (tb_lo + t) : 0;
            if (t + 1 < ntile) { const int t1 = t + 1; const int krow0 = (t1 < nbt) ? 128 * (n - 1) + 64 * (tb_lo + t1) : SEQ + 64 * (t1 - nbt);
#pragma unroll
                for (int i = 0; i < 2; ++i) { const int c = tid + 512 * i; kr[i] = *(const u32x4*)(kbase + (size_t)(krow0 + (c >> 4)) * 256 + (c & 15) * 8);
                    vr[i] = *(const u32x4*)(vbase + (size_t)(c >> 3) * KROWS + krow0 + (c & 7) * 8); } }
            if (band && (kp0 + 63 < q0 - 128 || kp0 > q0 + 31 + 128)) continue;
            f32x4 s[4][2];
#pragma unroll
            for (int kb = 0; kb < 4; ++kb)
#pragma unroll
                for (int qb = 0; qb < 2; ++qb) s[kb][qb] = (f32x4){0.f, 0.f, 0.f, 0.f};
#pragma unroll
            for (int kb = 0; kb < 4; ++kb)
#pragma unroll
                for (int ks = 0; ks < 4; ++ks) { const bf16x8 kf = *(const LAS bf16x8*)(lds + (16 * kb + fr) * KS_PITCH + (32 * ks + 8 * fq) * 2);
#pragma unroll
                    for (int qb = 0; qb < 2; ++qb) s[kb][qb] = __builtin_amdgcn_mfma_f32_16x16x32_bf16(kf, qf[qb][ks], s[kb][qb], 0, 0, 0); }
            if (band) {
#pragma unroll
                for (int kb = 0; kb < 4; ++kb)
#pragma unroll
                    for (int qb = 0; qb < 2; ++qb)
#pragma unroll
                        for (int r = 0; r < 4; ++r) { const int dq = (q0 + 16 * qb + fr) - (kp0 + 16 * kb + 4 * fq + r); if (dq > 128 || dq < -128) s[kb][qb][r] = -1e30f; }
            }
            bf16x8 pa[2][2];
#pragma unroll
            for (int qb = 0; qb < 2; ++qb) {
                float mx = s[0][qb][0];
#pragma unroll
                for (int kb = 0; kb < 4; ++kb)
#pragma unroll
                    for (int r = 0; r < 4; ++r) mx = fmaxf(mx, s[kb][qb][r]);
                mx = fmaxf(mx, __shfl_xor(mx, 16)); mx = fmaxf(mx, __shfl_xor(mx, 32));
                const float mn = fmaxf(m_[qb], mx), alpha = exp2f(m_[qb] - mn); m_[qb] = mn;
                float rs = 0.f;
#pragma unroll
                for (int kb = 0; kb < 4; ++kb)
#pragma unroll
                    for (int r = 0; r < 4; ++r) { const float pv = exp2f(s[kb][qb][r] - mn); rs += pv; s[kb][qb][r] = pv; }
                l_[qb] = l_[qb] * alpha + rs;
#pragma unroll
                for (int r = 0; r < 4; ++r) { const float ar = __shfl(alpha, 4 * fq + r);
#pragma unroll
                    for (int db = 0; db < 8; ++db) o[qb][db][r] *= ar; }
#pragma unroll
                for (int kk = 0; kk < 2; ++kk) { u32x4 w4; w4.x = cvt_pk_bf16(s[2 * kk][qb][0], s[2 * kk][qb][1]); w4.y = cvt_pk_bf16(s[2 * kk][qb][2], s[2 * kk][qb][3]);
                    w4.z = cvt_pk_bf16(s[2 * kk + 1][qb][0], s[2 * kk + 1][qb][1]); w4.w = cvt_pk_bf16(s[2 * kk + 1][qb][2], s[2 * kk + 1][qb][3]);
                    pa[qb][kk] = __builtin_bit_cast(bf16x8, w4); }
            }
#pragma unroll
            for (int kk = 0; kk < 2; ++kk)
#pragma unroll
                for (int db = 0; db < 8; ++db) { const LAS unsigned char* vp = lds + VT_OFF + (16 * db + fr) * VT_PITCH + (32 * kk + 4 * fq) * 2;
                    const u32x2 lo = *(const LAS u32x2*)vp, hi = *(const LAS u32x2*)(vp + 32);
                    u32x4 v4; v4.x = lo.x; v4.y = lo.y; v4.z = hi.x; v4.w = hi.y; const bf16x8 vf = __builtin_bit_cast(bf16x8, v4);
#pragma unroll
                    for (int qb = 0; qb < 2; ++qb) o[qb][db] = __builtin_amdgcn_mfma_f32_16x16x32_bf16(pa[qb][kk], vf, o[qb][db], 0, 0, 0); }
        }
#pragma unroll
        for (int qb = 0; qb < 2; ++qb) { float lt = l_[qb]; lt += __shfl_xor(lt, 16); lt += __shfl_xor(lt, 32); const float inv = 1.f / lt;
#pragma unroll
            for (int r = 0; r < 4; ++r) { const float ir = __shfl(inv, 4 * fq + r); bf16_t* dst = AO + (size_t)(b * SEQ + q0 + 16 * qb + 4 * fq + r) * QW + head * HD + fr;
#pragma unroll
                for (int db = 0; db < 8; ++db) dst[16 * db] = (bf16_t)f2bf(o[qb][db][r] * ir); } }
    }
    __syncthreads();
}

__device__ __forceinline__ void step_scan(int tid, int cblk, int nblk) {
    const int per = 32768 / nblk;
    if (tid >= per) return;
    const int idx = cblk * per + tid;
    const int pp = idx & 63, dir = (idx >> 6) & 1, b = (idx >> 7) & 7, g = idx >> 10;
    const float* LAMT = (const float*)(KP->ws + WS_LAMT);
    const float lr = LAMT[((g * 2 + dir) * 2 + 0) * 64 + pp], li = LAMT[((g * 2 + dir) * 2 + 1) * 64 + pp];
    const float* SL = (const float*)(KP->ws + WS_SLOC) + (size_t)g * S5ROWS * 256 + dir * 128 + pp;
    bf16_t* U = (bf16_t*)(KP->ws + WS_U) + (size_t)g * S5ROWS * 512 + 256 + dir * 128 + pp;
    float sr = 0.f, si = 0.f;
#define SCAN_ROW(s) (((s) < 16) ? (1024 + b * 16 + (dir ? 15 - (s) : (s))) : (b * 128 + (dir ? 127 - ((s) - 16) : ((s) - 16))))
#define SCAN_LOAD(xr, xi, c0) do { _Pragma("unroll") for (int q = 0; q < 16; ++q) { const int row = SCAN_ROW((c0) + q); xr[q] = SL[(size_t)row * 256]; xi[q] = SL[(size_t)row * 256 + 64]; } } while (0)
#define SCAN_STEP(xr, xi, c0) do { _Pragma("unroll") for (int q = 0; q < 16; ++q) { const int s = (c0) + q; \
        if (s >= 16) { const int row = SCAN_ROW(s); U[(size_t)row * 512] = (bf16_t)f2bf(sr); U[(size_t)row * 512 + 64] = (bf16_t)f2bf(si); } \
        const float t = lr * sr - li * si + xr[q]; si = lr * si + li * sr + xi[q]; sr = t; } } while (0)
    float ar[16], ai[16], br[16], bi[16];
    SCAN_LOAD(ar, ai, 0);
    for (int c0 = 0; c0 < 144; c0 += 32) {
        if (c0 + 16 < 144) SCAN_LOAD(br, bi, c0 + 16);
        SCAN_STEP(ar, ai, c0);
        if (c0 + 16 < 144) { if (c0 + 32 < 144) SCAN_LOAD(ar, ai, c0 + 32); SCAN_STEP(br, bi, c0 + 16); }
    }
#undef SCAN_ROW
#undef SCAN_LOAD
#undef SCAN_STEP
}

constexpr size_t WS_BAR = 0;
__device__ __forceinline__ void grid_bar(unsigned* ctr, unsigned target, bool leader) {
    asm volatile("s_waitcnt vmcnt(0)" ::: "memory");
    __syncthreads();
    if (leader) {
        __builtin_amdgcn_fence(__ATOMIC_RELEASE, "agent");
        asm volatile("s_waitcnt vmcnt(0)" ::: "memory");
        __hip_atomic_fetch_add(ctr, 1u, __ATOMIC_RELAXED, __HIP_MEMORY_SCOPE_AGENT);
        while (__hip_atomic_load(ctr, __ATOMIC_RELAXED, __HIP_MEMORY_SCOPE_AGENT) < target) __builtin_amdgcn_s_sleep(1);
        __builtin_amdgcn_fence(__ATOMIC_ACQUIRE, "agent");
        asm volatile("s_waitcnt vmcnt(0)" ::: "memory");
    }
    __syncthreads();
}

__global__ void __launch_bounds__(512, 2) fwd_kernel(Params p) {
    __builtin_assume(__builtin_amdgcn_workitem_id_y() == 0); __builtin_assume(__builtin_amdgcn_workitem_id_z() == 0);
    extern __shared__ __attribute__((aligned(16))) unsigned char lds_raw[];
    LAS unsigned char* lds = (LAS unsigned char*)lds_raw;
    unsigned char* ws = KP->ws;
    const int G = gridDim.x, c = blockIdx.x, lo = KP->lo, hi = KP->hi;
    const int wave_ = __builtin_amdgcn_readfirstlane(threadIdx.x >> 6);
#define TID (wave_ * 64 + lane_id())
#define IN(k) (lo <= (k) && (k) < hi)
    unsigned nbar = 0;
#define SEAM(k) do { if (IN(k) && IN((k) + 1)) { if ((k) == 0) cg::this_grid().sync(); else { ++nbar; grid_bar((unsigned*)(ws + WS_BAR), nbar * (unsigned)G, wave_ == 0 && lane_id() == 0); } } } while (0)
#define LSEAM(k) do { if (IN(k) && IN((k) + 1)) __syncthreads(); } while (0)
#define GG_ G
#define GEMM_STEP(k, MODE, Aoff, Boff, LDA, LDB, KK, OM, NM_, NN_, NWG, PA, PB, PC, OUTP) \
    if (IN(k)) for (int rep_ = 0; rep_ <= ((PROBE_MASK >> (k)) & 1); ++rep_) { const Gemm g{(const bf16_t*)(ws + (Aoff)), (const bf16_t*)(ws + (Boff)), LDA, LDB, KK}; const Order S{OM, NM_, NN_, NWG, GG_, c}; \
        const Epi<MODE> E{ws, PA, PB, PC, OUTP}; gemm_phase<MODE>(lds, g, S, E, TID); }
    const bool fused = (N_LAUNCH_MODE == 1) && (G == 256);
    if (IN(0)) for (int rep_ = 0; rep_ <= ((PROBE_MASK >> 0) & 1); ++rep_) { step_prologue(lds, TID); convert_weights(lds, TID, true, !fused, c * 8 + wave_, G * 8); __syncthreads(); }
    SEAM(0);
    if (IN(1)) for (int rep_ = 0; rep_ <= ((PROBE_MASK >> 1) & 1); ++rep_) { step_ln1(TID); __syncthreads(); }
    SEAM(1);
    GEMM_STEP(2, E_WIN, WS_HALL, WS_WTIN, DM, DM, DM, 1, 64, 24, 1568, nullptr, nullptr, nullptr, nullptr)
    if (fused && IN(2) && c >= 32) convert_weights(lds, TID, false, true, (c - 32) * 8 + wave_, (G - 32) * 8);
    SEAM(2);
    {
        const int NC = fused ? 128 : G;
        unsigned nsub = 0;
#define CH_SEAM(k) do { if (IN(k) && IN((k) + 1)) { if (fused) { ++nsub; grid_bar((unsigned*)(ws + WS_BAR) + 64, nsub * (unsigned)NC, wave_ == 0 && lane_id() == 0); } \
                                                    else { ++nbar; grid_bar((unsigned*)(ws + WS_BAR), nbar * (unsigned)G, wave_ == 0 && lane_id() == 0); } } } while (0)
        if (c < NC) {
#undef GG_
#define GG_ NC
            GEMM_STEP(4, E_S5A, WS_U, WS_WMAT, 512, 256, 256, 2, 5, 1, 160, nullptr, nullptr, nullptr, nullptr)
            CH_SEAM(4);
            if (IN(5)) for (int rep_ = 0; rep_ <= ((PROBE_MASK >> 5) & 1); ++rep_) { step_scan(TID, c, NC); __syncthreads(); }
            CH_SEAM(5);
            GEMM_STEP(6, E_S5C, WS_U, WS_MMAT, 512, 512, 512, 2, 4, 1, 128, nullptr, nullptr, nullptr, nullptr)
            CH_SEAM(6);
            GEMM_STEP(7, E_GLU, WS_SACT, WS_WTGLU, SW, SW, SW, 0, 64, 4, 256, nullptr, nullptr, nullptr, nullptr)
#undef GG_
#define GG_ G
        }
#undef CH_SEAM
        if (IN(3)) for (int rep_ = 0; rep_ <= ((PROBE_MASK >> 3) & 1); ++rep_) {
            __syncthreads();
            if (fused) { if (c >= 128) step_attn(lds, TID, 4 * (c - 128), 4, 1); }
            else step_attn(lds, TID, c, (512 - c + G - 1) / G, G);
            __syncthreads(); }
        if (hi > 8 && lo <= 7) { ++nbar; grid_bar((unsigned*)(ws + WS_BAR), nbar * (unsigned)G, wave_ == 0 && lane_id() == 0); }
    }
    GEMM_STEP(8, E_AUP, WS_ATTN, WS_WTAUP, QW, QW, QW, 0, 64, 8, 512, nullptr, nullptr, nullptr, nullptr)
    LSEAM(8);
    GEMM_STEP(9, E_SUP, WS_SGLU, WS_WTSUP, SW, SW, SW, 0, 64, 8, 512, nullptr, nullptr, nullptr, nullptr)
    SEAM(9);
    if (fused) { GEMM_STEP(10, E_WOUTF, WS_MERG, WS_WTOUT, DM, DM, DM, 3, 64, 8, 512, KP->in[0], KP->in[20], KP->in[21], KP->out) }
    else { GEMM_STEP(10, E_WOUT, WS_MERG, WS_WTOUT, DM, DM, DM, 0, 64, 8, 512, KP->in[0], nullptr, nullptr, KP->out) }
    SEAM(10);
    if (!fused) { if (IN(11)) step_ln2(TID);
    SEAM(11); }
    GEMM_STEP(12, E_M1, WS_H2, WS_WTM1, DM, DM, DM, 0, 64, 32, 2048, KP->in[23], nullptr, nullptr, nullptr)
    SEAM(12);
    if (fused) { GEMM_STEP(13, E_M2F, WS_HID, WS_WTM2, DFF, DFF, DFF, 3, 64, 8, 512, KP->in[25], KP->in[26], KP->in[27], KP->out) }
    else { GEMM_STEP(13, E_M2, WS_HID, WS_WTM2, DFF, DFF, DFF, 0, 64, 8, 512, KP->in[25], nullptr, nullptr, KP->out)
    SEAM(13);
    if (IN(14)) step_ln3(TID); }
#undef IN
#undef TID
#undef SEAM
#undef LSEAM
#undef GEMM_STEP
#undef GG_
}

extern "C" void kernel_launch(void* const* d_in, const int* in_sizes, int n_in, void* d_out, int out_size, void* d_ws, size_t ws_size, hipStream_t stream) {
    static int grid = 0;
    if (grid == 0) {
        if (n_in != 28 || out_size != MLAT * DM || ws_size < WS_NEED) { fprintf(stderr, "kernel_launch: unexpected shapes (n_in %d out %d ws %zu)\n", n_in, out_size, ws_size); grid = -1; return; }
        int dev = 0, cus = 0, per_cu = 0;
        hipGetDevice(&dev); hipDeviceGetAttribute(&cus, hipDeviceAttributeMultiprocessorCount, dev);
        if (hipFuncSetAttribute((const void*)fwd_kernel, hipFuncAttributeMaxDynamicSharedMemorySize, LDS_BYTES) != hipSuccess) { fprintf(stderr, "kernel_launch: hipFuncSetAttribute failed\n"); grid = -1; return; }
        if (hipOccupancyMaxActiveBlocksPerMultiprocessor(&per_cu, (const void*)fwd_kernel, 512, LDS_BYTES) != hipSuccess || per_cu < 1) { fprintf(stderr, "kernel_launch: occupancy query gives %d\n", per_cu); (void)hipGetLastError(); per_cu = 1; }
        grid = cus;
        if (grid <= 0) grid = 256;
    }
    if (grid < 0) return;
    Params p{};
    for (int i = 0; i < 28; ++i) p.in[i] = (const float*)d_in[i];
    p.out = (float*)d_out; p.ws = (unsigned char*)d_ws;
#if N_LAUNCH_MODE == 1
    if (hipMemsetAsync((char*)d_ws + WS_BAR, 0, WS_CTL_BYTES, stream) != hipSuccess) { fprintf(stderr, "kernel_launch: memset failed\n"); return; }
    p.lo = 0; p.hi = NSTEPS;
    void* args[] = {&p};
    hipError_t e = hipLaunchCooperativeKernel((const void*)fwd_kernel, dim3(grid), dim3(512), args, LDS_BYTES, stream);
    if (e != hipSuccess) fprintf(stderr, "cooperative launch failed: %s (grid %d)\n", hipGetErrorString(e), grid);
#else
    for (int st = 0; st < NSTEPS; ++st) {
        p.lo = st; p.hi = st + 1;
        hipLaunchKernelGGL(fwd_kernel, dim3(grid), dim3(512), LDS_BYTES, stream, p);
    }
#endif
}
```
